# Optimizing an MI355X kernel written in HIP

```python
import jax
import jax.numpy as jnp
from jax import lax
import numpy as np

D_MODEL = 1024
BATCH = 16
SEQ = 4096
DEPTH = 4

CTX_LEN = 256
GRID_W = 64

DN_HEADS = 4
DN_DK = 128
DN_DV = 128
SSM_HEADS = 8
SSM_P = 64
SSM_N = 128
SSM_G = 2
CHUNK = 64
CONV_K = 3
N_EXPERTS = 16
EC_CAPACITY_FACTOR = 2
D_EXPERT = 512
EPS = 1e-6

DN_QK = DN_HEADS * DN_DK
DN_VW = DN_HEADS * DN_DV
SSM_DI = SSM_HEADS * SSM_P
SSM_BC = SSM_G * SSM_N
D_MIX = DN_VW + SSM_DI
CONV_SPLITS = (DN_QK, DN_QK, DN_VW, SSM_DI, SSM_BC, SSM_BC)
CONV_CH = sum(CONV_SPLITS)
REST_SPLITS = (DN_VW, SSM_DI, 2 * DN_HEADS, 2 * DN_HEADS, 2 * SSM_HEADS)
D_IN_PROJ = CONV_CH + sum(REST_SPLITS)

kernel_name = "hybrid_dit_deltanet_ssd_ecmoe"


def _split(a, sizes):
    return jnp.split(a, np.cumsum(sizes)[:-1].tolist(), axis=-1)


def _rev(a):
    return a[:, ::-1]


def rms_norm(x, g):
    xf = x.astype(jnp.float32)
    y = xf * lax.rsqrt(jnp.mean(xf * xf, axis=-1, keepdims=True) + EPS)
    return (y * g.astype(jnp.float32)).astype(x.dtype)


def l2_normalize(x):
    xf = x.astype(jnp.float32)
    return xf * lax.rsqrt(jnp.sum(xf * xf, axis=-1, keepdims=True) + EPS)


def modulate(h, shift, scale):
    return h * (1.0 + scale) + shift


def conv_grid(u, w, b):
    bsz, t, ch = u.shape
    rows = t // GRID_W
    img = u.reshape(bsz, rows, GRID_W, ch)
    kern = jnp.transpose(w, (1, 2, 0))[:, :, None, :].astype(u.dtype)
    out = lax.conv_general_dilated(img, kern, window_strides=(1, 1), padding="SAME",
                                   dimension_numbers=("NHWC", "HWIO", "NHWC"),
                                   feature_group_count=ch)
    return out.reshape(bsz, t, ch) + b.astype(u.dtype)


def conv_seq(u, w, b):
    taps = w[:, CONV_K // 2, :].astype(u.dtype)
    t = u.shape[1]
    pad = CONV_K // 2
    up = jnp.pad(u, ((0, 0), (pad, pad), (0, 0)))
    out = sum(up[:, i:i + t] * taps[:, i] for i in range(CONV_K))
    return out + b.astype(u.dtype)


def stream_features(h, w_in, conv_w, conv_b, on_grid):
    bsz, t = h.shape[:2]
    proj = jnp.einsum("btd,de->bte", h, w_in)
    conv_in, rest = proj[..., :CONV_CH], proj[..., CONV_CH:]
    conv = conv_grid if on_grid else conv_seq
    u = jax.nn.silu(conv(conv_in, conv_w, conv_b)).astype(jnp.float32)
    q, k, v, xs, bs, cs = _split(u, CONV_SPLITS)
    dn_z, ssm_z, dn_b, dn_a, ssm_dt = _split(rest.astype(jnp.float32), REST_SPLITS)
    return dict(
        q=l2_normalize(q.reshape(bsz, t, DN_HEADS, DN_DK)) * (DN_DK ** -0.5),
        k=l2_normalize(k.reshape(bsz, t, DN_HEADS, DN_DK)),
        v=v.reshape(bsz, t, DN_HEADS, DN_DV),
        x=xs.reshape(bsz, t, SSM_HEADS, SSM_P),
        B=bs.reshape(bsz, t, SSM_G, SSM_N),
        C=cs.reshape(bsz, t, SSM_G, SSM_N),
        dn_z=dn_z,
        ssm_z=ssm_z,
        dn_b=dn_b.reshape(bsz, t, 2, DN_HEADS),
        dn_a=dn_a.reshape(bsz, t, 2, DN_HEADS),
        ssm_dt=ssm_dt.reshape(bsz, t, 2, SSM_HEADS),
    )


def gated_delta_chunked(q, k, v, beta, logg, S0, with_output):
    bsz, t, nh, dk = k.shape
    dv = v.shape[-1]
    nc = t // CHUNK

    def to_chunks(a):
        a = a.reshape(bsz, nc, CHUNK, nh, *a.shape[3:])
        return jnp.moveaxis(a, (1, 3), (0, 2))

    qc, kc, vc, bc, gc = map(to_chunks, (q, k, v, beta, logg))
    G = jnp.cumsum(gc, axis=-1)
    tri = jnp.tril(jnp.ones((CHUNK, CHUNK), dtype=bool))
    strict = jnp.tril(jnp.ones((CHUNK, CHUNK), dtype=bool), -1)
    decay = jnp.where(tri, jnp.exp(jnp.where(tri, G[..., :, None] - G[..., None, :], 0.0)), 0.0)
    kb = kc * bc[..., None]
    lmat = jnp.where(strict, jnp.einsum("cbhid,cbhjd->cbhij", kb, kc) * decay, 0.0)
    rhs = jnp.concatenate([vc * bc[..., None], kb * jnp.exp(G)[..., None]], axis=-1)
    uw = lax.linalg.triangular_solve(lmat + jnp.eye(CHUNK, dtype=lmat.dtype), rhs,
                                     left_side=True, lower=True, unit_diagonal=True)
    u, w = uw[..., :dv], uw[..., dv:]
    g_last = G[..., -1]
    k_tail = kc * jnp.exp(g_last[..., None] - G)[..., None]

    def step(S, inp):
        u_i, w_i, kt_i, gl_i = inp[:4]
        v_new = u_i - jnp.einsum("bhld,bhdv->bhlv", w_i, S)
        if with_output:
            qg_i, qk_i = inp[4:]
            o = jnp.einsum("bhld,bhdv->bhlv", qg_i, S) + jnp.einsum("bhij,bhjv->bhiv", qk_i, v_new)
        else:
            o = None
        S = S * jnp.exp(gl_i)[..., None, None] + jnp.einsum("bhld,bhlv->bhdv", kt_i, v_new)
        return S, o

    xs = (u, w, k_tail, g_last)
    if with_output:
        qk = jnp.where(tri, jnp.einsum("cbhid,cbhjd->cbhij", qc, kc) * decay, 0.0)
        qg = qc * jnp.exp(G)[..., None]
        xs = xs + (qg, qk)
    S_T, o = lax.scan(step, S0, xs)
    if not with_output:
        return None, S_T
    o = jnp.moveaxis(o, (0, 2), (1, 3)).reshape(bsz, t, nh, dv)
    return o, S_T


def ssd_chunked(x, dt, A, Bm, Cm, h0, with_output):
    bsz, t, nh, hp = x.shape
    ng, ns = Bm.shape[2], Bm.shape[3]
    hpg = nh // ng
    nc = t // CHUNK
    xc = jnp.transpose(x.reshape(bsz, nc, CHUNK, ng, hpg, hp), (1, 0, 3, 4, 2, 5))
    dtc = jnp.transpose(dt.reshape(bsz, nc, CHUNK, ng, hpg), (1, 0, 3, 4, 2))
    Bc = jnp.transpose(Bm.reshape(bsz, nc, CHUNK, ng, ns), (1, 0, 3, 2, 4))
    Cc = jnp.transpose(Cm.reshape(bsz, nc, CHUNK, ng, ns), (1, 0, 3, 2, 4))
    Acs = jnp.cumsum(dtc * A.reshape(ng, hpg, 1), axis=-1)
    xdt = xc * dtc[..., None]

    def step(h, inp):
        B_i, C_i, xdt_i, a_i = inp
        a_last = a_i[..., -1:]
        if with_output:
            y_off = jnp.einsum("bgin,bghnp->bghip", C_i, h) * jnp.exp(a_i)[..., None]
        else:
            y_off = None
        st = jnp.einsum("bgjn,bghjp->bghnp", B_i, xdt_i * jnp.exp(a_last - a_i)[..., None])
        h = h * jnp.exp(a_last)[..., None] + st
        return h, y_off

    hT, y_off = lax.scan(step, h0.reshape(bsz, ng, hpg, ns, hp), (Bc, Cc, xdt, Acs))
    hT = hT.reshape(bsz, nh, ns, hp)
    if not with_output:
        return None, hT
    tri = jnp.tril(jnp.ones((CHUNK, CHUNK), dtype=bool))
    decay = jnp.where(tri, jnp.exp(jnp.where(tri, Acs[..., :, None] - Acs[..., None, :], 0.0)), 0.0)
    scores = jnp.einsum("cbgin,cbgjn->cbgij", Cc, Bc)[:, :, :, None] * decay
    y_diag = jnp.einsum("cbghij,cbghjp->cbghip", scores, xdt)
    y = jnp.transpose(y_diag + y_off, (1, 0, 4, 2, 3, 5)).reshape(bsz, t, nh, hp)
    return y, hT


def dn_inputs(f, d, A_log, dt_bias):
    beta = jax.nn.sigmoid(f["dn_b"][:, :, d])
    logg = -jnp.exp(A_log[d]) * jax.nn.softplus(f["dn_a"][:, :, d] + dt_bias[d])
    args = (f["q"], f["k"], f["v"], beta, logg)
    return tuple(_rev(a) for a in args) if d == 1 else args


def ssd_inputs(f, d, A_log, dt_bias):
    dt = jax.nn.softplus(f["ssm_dt"][:, :, d] + dt_bias[d])
    seq_args = (f["x"], dt, f["B"], f["C"])
    if d == 1:
        seq_args = tuple(_rev(a) for a in seq_args)
    x, dt, Bm, Cm = seq_args
    return x, dt, -jnp.exp(A_log[d]).astype(jnp.float32), Bm, Cm


def merge_heads(f, o_dirs, y_dirs, dn_norm_g, ssm_D, ssm_norm_g, w_out, out_dtype):
    o = o_dirs[0] + o_dirs[1]
    bsz, t = o.shape[:2]
    dn = rms_norm(o, dn_norm_g) * jax.nn.silu(f["dn_z"].reshape(o.shape))
    y = y_dirs[0] + y_dirs[1] + ssm_D[:, None] * f["x"]
    yz = y.reshape(bsz, t, SSM_DI) * jax.nn.silu(f["ssm_z"])
    ssm = rms_norm(yz.reshape(bsz, t, SSM_G, SSM_DI // SSM_G),
                   ssm_norm_g.reshape(SSM_G, SSM_DI // SSM_G)).reshape(bsz, t, SSM_DI)
    mixed = jnp.concatenate([dn.reshape(bsz, t, DN_VW), ssm], axis=-1).astype(out_dtype)
    return jnp.einsum("bte,ed->btd", mixed, w_out)


def hybrid_mixer(h_ctx, h_lat, w_in, conv_w, conv_b, dn_A_log, dn_dt_bias, dn_norm_g,
                 ssm_A_log, ssm_dt_bias, ssm_D, ssm_norm_g, w_out, ctx_out):
    fc = stream_features(h_ctx, w_in, conv_w, conv_b, on_grid=False)
    fl = stream_features(h_lat, w_in, conv_w, conv_b, on_grid=True)
    bsz = h_lat.shape[0]
    dn_c, dn_l, ssm_c, ssm_l = [], [], [], []
    for d in range(2):
        unrev = _rev if d == 1 else (lambda a: a)
        S0 = jnp.zeros((bsz, DN_HEADS, DN_DK, DN_DV), jnp.float32)
        o_c, S_c = gated_delta_chunked(*dn_inputs(fc, d, dn_A_log, dn_dt_bias), S0, ctx_out)
        o_l, _ = gated_delta_chunked(*dn_inputs(fl, d, dn_A_log, dn_dt_bias), S_c, True)
        h0 = jnp.zeros((bsz, SSM_HEADS, SSM_N, SSM_P), jnp.float32)
        y_c, H_c = ssd_chunked(*ssd_inputs(fc, d, ssm_A_log, ssm_dt_bias), h0, ctx_out)
        y_l, _ = ssd_chunked(*ssd_inputs(fl, d, ssm_A_log, ssm_dt_bias), H_c, True)
        dn_l.append(unrev(o_l))
        ssm_l.append(unrev(y_l))
        if ctx_out:
            dn_c.append(unrev(o_c))
            ssm_c.append(unrev(y_c))
    m_lat = merge_heads(fl, dn_l, ssm_l, dn_norm_g, ssm_D, ssm_norm_g, w_out, h_lat.dtype)
    m_ctx = merge_heads(fc, dn_c, ssm_c, dn_norm_g, ssm_D, ssm_norm_g, w_out, h_ctx.dtype) if ctx_out else None
    return m_ctx, m_lat


def ec_moe(h, router_w, w_gate, w_up, w_down):
    bsz, t, _ = h.shape
    cap = EC_CAPACITY_FACTOR * t // N_EXPERTS
    aff = jax.nn.softmax(jnp.einsum("btd,de->bte", h, router_w).astype(jnp.float32), axis=-1)
    gate, idx = lax.top_k(jnp.swapaxes(aff, 1, 2), cap)
    bidx = jnp.arange(bsz)[:, None, None]
    xs = h[bidx, idx]
    hid = jax.nn.silu(jnp.einsum("becd,edf->becf", xs, w_gate)) * jnp.einsum("becd,edf->becf", xs, w_up)
    ye = jnp.einsum("becf,efd->becd", hid, w_down) * gate[..., None].astype(h.dtype)
    return jnp.zeros_like(h).at[bidx, idx].add(ye)


def setup_inputs(seed: int = 0) -> dict:
    key = jax.random.key(seed)
    ks = jax.random.split(key, 24)
    f32 = jnp.float32

    def nrm(k, shape, scale):
        return jax.random.normal(k, shape, f32) * scale

    def a_log(k, shape):
        return jnp.log(jax.random.uniform(k, shape, f32, 1.0, 16.0))

    def dt_bias(k, shape):
        dt = jnp.exp(jax.random.uniform(k, shape, f32, float(np.log(1e-3)), float(np.log(1e-1))))
        return dt + jnp.log(-jnp.expm1(-dt))

    return {
        "x": nrm(ks[0], (BATCH, SEQ, D_MODEL), 1.0),
        "c": nrm(ks[1], (BATCH, D_MODEL), 1.0),
        "ctx": nrm(ks[2], (BATCH, CTX_LEN, D_MODEL), 1.0),
        "c_ctx": nrm(ks[3], (D_MODEL,), 1.0),
        "ada_w": nrm(ks[4], (DEPTH, D_MODEL, 6 * D_MODEL), 0.3 * D_MODEL ** -0.5),
        "ada_b": nrm(ks[5], (DEPTH, 6 * D_MODEL), 0.02),
        "norm_g": 1.0 + nrm(ks[6], (DEPTH, 4, D_MODEL), 0.1),
        "w_in": nrm(ks[7], (DEPTH, D_MODEL, D_IN_PROJ), D_MODEL ** -0.5),
        "conv_w": nrm(ks[8], (DEPTH, CONV_CH, CONV_K, CONV_K), 1.0 / CONV_K),
        "conv_b": nrm(ks[9], (DEPTH, CONV_CH), 0.02),
        "dn_A_log": a_log(ks[10], (DEPTH, 2, DN_HEADS)),
        "dn_dt_bias": dt_bias(ks[11], (DEPTH, 2, DN_HEADS)),
        "dn_norm_g": 1.0 + nrm(ks[12], (DEPTH, DN_DV), 0.1),
        "ssm_A_log": a_log(ks[13], (DEPTH, 2, SSM_HEADS)),
        "ssm_dt_bias": dt_bias(ks[14], (DEPTH, 2, SSM_HEADS)),
        "ssm_D": 1.0 + nrm(ks[15], (DEPTH, SSM_HEADS), 0.1),
        "ssm_norm_g": 1.0 + nrm(ks[16], (DEPTH, SSM_DI), 0.1),
        "w_out": nrm(ks[17], (DEPTH, D_MIX, D_MODEL), D_MIX ** -0.5),
        "router_w": nrm(ks[18], (DEPTH, D_MODEL, N_EXPERTS), D_MODEL ** -0.5),
        "exp_w_gate": nrm(ks[19], (DEPTH, N_EXPERTS, D_MODEL, D_EXPERT), D_MODEL ** -0.5),
        "exp_w_up": nrm(ks[20], (DEPTH, N_EXPERTS, D_MODEL, D_EXPERT), D_MODEL ** -0.5),
        "exp_w_down": nrm(ks[21], (DEPTH, N_EXPERTS, D_EXPERT, D_MODEL), D_EXPERT ** -0.5),
    }


def reference(x, c, ctx, c_ctx, ada_w, ada_b, norm_g, w_in, conv_w, conv_b, dn_A_log, dn_dt_bias,
              dn_norm_g, ssm_A_log, ssm_dt_bias, ssm_D, ssm_norm_g, w_out, router_w,
              exp_w_gate, exp_w_up, exp_w_down):
    s_lat = jax.nn.silu(c)
    s_ctx = jax.nn.silu(c_ctx)
    for l in range(DEPTH):
        last = l == DEPTH - 1
        mod_lat = jnp.split((s_lat @ ada_w[l] + ada_b[l])[:, None, :], 6, axis=-1)
        n_ctx_mod = 2 if last else 6
        mod_ctx = jnp.split((s_ctx @ ada_w[l][:, :n_ctx_mod * D_MODEL]
                             + ada_b[l][:n_ctx_mod * D_MODEL])[None, None, :], n_ctx_mod, axis=-1)

        h_lat = modulate(rms_norm(x, norm_g[l, 0]), mod_lat[0], mod_lat[1])
        h_ctx = modulate(rms_norm(ctx, norm_g[l, 0]), mod_ctx[0], mod_ctx[1])
        m_ctx, m_lat = hybrid_mixer(h_ctx, h_lat, w_in[l], conv_w[l], conv_b[l], dn_A_log[l],
                                    dn_dt_bias[l], dn_norm_g[l], ssm_A_log[l], ssm_dt_bias[l],
                                    ssm_D[l], ssm_norm_g[l], w_out[l], ctx_out=not last)
        x = x + mod_lat[2] * rms_norm(m_lat, norm_g[l, 1])

        h_lat = modulate(rms_norm(x, norm_g[l, 2]), mod_lat[3], mod_lat[4])
        y_lat = ec_moe(h_lat, router_w[l], exp_w_gate[l], exp_w_up[l], exp_w_down[l])
        x = x + mod_lat[5] * rms_norm(y_lat, norm_g[l, 3])

        if not last:
            ctx = ctx + mod_ctx[2] * rms_norm(m_ctx, norm_g[l, 1])
            h_ctx = modulate(rms_norm(ctx, norm_g[l, 2]), mod_ctx[3], mod_ctx[4])
            y_ctx = ec_moe(h_ctx, router_w[l], exp_w_gate[l], exp_w_up[l], exp_w_down[l])
            ctx = ctx + mod_ctx[5] * rms_norm(y_ctx, norm_g[l, 3])
    return x
```

```cpp
#include <hip/hip_runtime.h>
#include <cstdio>
#include <cstdint>

#ifndef SCAN_NAIVE
#define SCAN_NAIVE 0
#endif
#ifndef PROBE_SUBST_LO
#define PROBE_SUBST_LO 0
#endif
#ifndef PROBE_QK
#define PROBE_QK 1
#endif
#ifndef PROBE_SSD
#define PROBE_SSD 1
#endif
#ifndef PROBE_DN
#define PROBE_DN 1
#endif
#ifndef PROBE_SS
#define PROBE_SS 1
#endif
#ifndef PROBE_DUP_MASK
#define PROBE_DUP_MASK 0
#endif
#ifndef PREP_OLD
#define PREP_OLD 0
#endif
#ifndef MK_MULTI
#define MK_MULTI 0
#endif

namespace pg8 {
#define PG8_LAS __attribute__((address_space(3)))
typedef unsigned short bf16_t;
typedef short bf16x8 __attribute__((ext_vector_type(8)));
typedef float f32x4 __attribute__((ext_vector_type(4)));
typedef unsigned u32x4 __attribute__((ext_vector_type(4)));
constexpr int BM = 256, BK = 64, HALF = 128, HTB = HALF * BK * 2, STAGE_BYTES = 8 * HTB, NXCD = 8, WGM = 8;

__host__ __device__ __forceinline__ int lds_byte(int r, int c) { const int st = (r >> 4) * 2 + (c >> 5), rr = r & 15, cc = c & 31, ob = rr * 64 + cc * 2; return st * 1024 + (ob ^ (((ob >> 9) & 1) << 5)); }
__host__ __device__ __forceinline__ void stage_rc(int b, int& R, int& C) { const int st = b / 1024, sb = b % 1024, swz = sb ^ (((sb >> 9) & 1) << 5); R = (st >> 1) * 16 + swz / 64; C = (st & 1) * 32 + (swz % 64) / 2; }
__host__ __device__ __forceinline__ int perm32(int rho) { const int n = rho >> 4, i = rho & 15; return 8 * (i >> 2) + 4 * n + (i & 3); }

struct Unit { int pm, pn; };
struct Gemm { const bf16_t* A; const bf16_t* Bt; int M, N, K; };

struct StaticOrder {
    int nM, nN, nwg, G, c;
    __host__ __device__ void init(int M, int N, int G_, int c_) { nM = M / BM; nN = N / BM; nwg = nM * nN; G = G_; c = c_; }
    __host__ __device__ bool next(int i, Unit& u) const {
        const long L = (long)i * G + c; if (L >= nwg) return false;
        int wgid = (int)L; { const int q = nwg / NXCD, r = nwg % NXCD, xcd = wgid % NXCD, off = wgid / NXCD; wgid = (xcd < r ? xcd * (q + 1) : r * (q + 1) + (xcd - r) * q) + off; }
        const int nig = WGM * nN, gid = wgid / nig, fm = gid * WGM, gsz = (nM - fm) < WGM ? (nM - fm) : WGM;
        u.pm = fm + ((wgid % nig) % gsz); u.pn = (wgid % nig) / gsz; return true;
    }
    __device__ __forceinline__ void a_ready(const Unit&) const {}
    __device__ __forceinline__ void done(const Unit&) const {}
};
struct MoeOrder {
    int nM, G, c;
    __device__ bool next(int i, Unit& u) const {
        if (G & 31) { const long L = (long)i * G + c; if (L >= 4L * nM) return false; const int pm0 = (int)(L >> 2); u.pm = pm0; u.pn = (((pm0 >> 1) & 15) << 2) | (int)(L & 3); return true; }
        const int xcd = c & 7, q = c >> 3, j = q & 3, slot = q >> 2;
        const int pm = (G == 256) ? i * 64 + (slot >> 2) * 32 + 4 * xcd + (slot & 3) : i * (G >> 2) + slot * 8 + xcd; if (pm >= nM) return false;
        u.pm = pm; u.pn = (((pm >> 1) & 15) << 2) | j; return true;
    }
    __device__ __forceinline__ void a_ready(const Unit&) const {}
    __device__ __forceinline__ void done(const Unit&) const {}
};

__device__ __forceinline__ unsigned cvt_pk_bf16(float lo, float hi) { unsigned r; asm volatile("v_cvt_pk_bf16_f32 %0, %1, %2" : "=v"(r) : "v"(lo), "v"(hi)); return r; }

template <class Epi, class Sched>
__device__ __forceinline__ void gemm_phase(PG8_LAS unsigned char* lds, const Gemm g, const Sched& S, const Epi& E, const int tid) {
    const int wid = __builtin_amdgcn_readfirstlane(tid >> 6), lane = tid & 63, wr = wid >> 2, wc = wid & 3, fr = lane & 15, fq = lane >> 4;
    const int K = g.K, nt = K / BK;
    unsigned voffA[2], voffB[2];
#pragma unroll
    for (int i = 0; i < 2; ++i) { int R, C; stage_rc(tid * 16 + i * 8192, R, C);
        const int Rb = Epi::WIDE ? (64 * (R >> 5) + perm32(R & 31)) : (Epi::PERM ? ((R & ~31) + perm32(R & 31)) : R);
        voffA[i] = (unsigned)(R * K + C) * 2u; voffB[i] = (unsigned)(Rb * K + C) * 2u; }
    const size_t kstep = (size_t)(BK * 2);
    const size_t hstep = (size_t)HALF * K * 2;
    const size_t bhs = Epi::WIDE ? (size_t)32 * K * 2 : hstep;
    const size_t tstep = 2 * hstep;
    const unsigned ldsw = (unsigned)wid * 1024u;
    const int aoff = lds_byte(wr * 64 + fr, fq * 8), boff = lds_byte(wc * 32 + fr, fq * 8);
#define PG8_SA(b, h) (((b) * 2 + (h)) * HTB)
#define PG8_SB(b, h) ((4 + (b) * 2 + (h)) * HTB)
#define PG8_STAGE(bufoff, gbase, voff) do { _Pragma("unroll") for (int _i = 0; _i < 2; ++_i) \
        __builtin_amdgcn_global_load_lds((const unsigned*)((const char*)(gbase) + (voff)[_i]), (PG8_LAS unsigned*)(lds + (bufoff) + ldsw + _i * 8192), 16, 0, 0); } while (0)
#define PG8_LDA(dst, b, h) do { _Pragma("unroll") for (int m = 0; m < 4; ++m) _Pragma("unroll") for (int k = 0; k < 2; ++k) dst[m][k] = *(const PG8_LAS bf16x8*)(lds + PG8_SA(b, h) + aoff + m * 2048 + k * 1024); } while (0)
#define PG8_LDB(dst, b, h) do { _Pragma("unroll") for (int n = 0; n < 2; ++n) _Pragma("unroll") for (int k = 0; k < 2; ++k) dst[n][k] = *(const PG8_LAS bf16x8*)(lds + PG8_SB(b, h) + boff + n * 2048 + k * 1024); } while (0)
#define PG8_MMA(ai, bj, At, Bt) do { __builtin_amdgcn_s_setprio(1); _Pragma("unroll") for (int m = 0; m < 4; ++m) _Pragma("unroll") for (int n = 0; n < 2; ++n) _Pragma("unroll") for (int k = 0; k < 2; ++k) \
        acc[ai][bj][m][n] = __builtin_amdgcn_mfma_f32_16x16x32_bf16(Bt[n][k], At[m][k], acc[ai][bj][m][n], 0, 0, 0); __builtin_amdgcn_s_setprio(0); } while (0)
#define PG8_WAIT_V(n) asm volatile("s_waitcnt vmcnt(" #n ")" ::: "memory")
#define PG8_WAIT_L(n) asm volatile("s_waitcnt lgkmcnt(" #n ")" ::: "memory")
#define PG8_BAR __builtin_amdgcn_s_barrier()
#define PG8_SCHED __builtin_amdgcn_sched_barrier(0)
    Unit cur, nxt; int ui = 0;
    if (!S.next(0, cur)) return;
    f32x4 acc[2][2][4][2];
#pragma unroll
    for (int a = 0; a < 2; ++a)
#pragma unroll
        for (int b = 0; b < 2; ++b)
#pragma unroll
            for (int m = 0; m < 4; ++m)
#pragma unroll
                for (int n = 0; n < 2; ++n) acc[a][b][m][n] = (f32x4){0.f, 0.f, 0.f, 0.f};
    bf16x8 At[4][2], B0[2][2], B1[2][2];
    const char* cA = (const char*)g.A + (size_t)cur.pm * tstep; const char* cB = (const char*)g.Bt + (size_t)cur.pn * tstep;
    S.a_ready(cur);
    PG8_STAGE(PG8_SB(0, 0), cB, voffB); PG8_STAGE(PG8_SB(0, 1), cB + bhs, voffB); PG8_STAGE(PG8_SA(0, 0), cA, voffA); PG8_STAGE(PG8_SA(0, 1), cA + hstep, voffA);
    if (wr == 1) PG8_BAR;
    PG8_WAIT_V(2); PG8_BAR;
    PG8_STAGE(PG8_SB(1, 0), cB + kstep, voffB); PG8_STAGE(PG8_SA(1, 0), cA + kstep, voffA); PG8_STAGE(PG8_SB(1, 1), cB + bhs + kstep, voffB);
    PG8_WAIT_V(6); PG8_BAR;
    for (;;) {
        const bool has_next = S.next(ui + 1, nxt);
        const char* nA = has_next ? (const char*)g.A + (size_t)nxt.pm * tstep : cA; const char* nB = has_next ? (const char*)g.Bt + (size_t)nxt.pn * tstep : cB;
        for (int t = 0; t < nt; t += 2) {
            const bool last = (t == nt - 2);
            const char* a1 = cA + (size_t)(t + 1) * kstep;
            const char* a2 = last ? nA : cA + (size_t)(t + 2) * kstep; const char* b2 = last ? nB : cB + (size_t)(t + 2) * kstep;
            const char* a3 = a2 + kstep; const char* b3 = b2 + kstep;
            if (last && has_next) S.a_ready(nxt);
            PG8_LDB(B0, 0, 0); PG8_LDB(B1, 0, 1); PG8_SCHED; PG8_LDA(At, 0, 0); PG8_STAGE(PG8_SA(1, 1), a1 + hstep, voffA);
            PG8_WAIT_V(8); PG8_WAIT_L(0); PG8_BAR; PG8_MMA(0, 0, At, B0); PG8_MMA(0, 1, At, B1); PG8_BAR; PG8_SCHED;
            PG8_LDA(At, 0, 1); PG8_STAGE(PG8_SB(0, 0), b2, voffB); PG8_STAGE(PG8_SB(0, 1), b2 + bhs, voffB); PG8_STAGE(PG8_SA(0, 0), a2, voffA);
            PG8_WAIT_V(8); PG8_WAIT_L(0); PG8_BAR; PG8_MMA(1, 0, At, B0); PG8_MMA(1, 1, At, B1); PG8_BAR; PG8_SCHED;
            PG8_LDB(B0, 1, 0); PG8_LDB(B1, 1, 1); PG8_SCHED; PG8_LDA(At, 1, 0); PG8_STAGE(PG8_SA(0, 1), a2 + hstep, voffA);
            PG8_WAIT_V(8); PG8_WAIT_L(0); PG8_BAR; PG8_MMA(0, 0, At, B0); PG8_MMA(0, 1, At, B1); PG8_BAR; PG8_SCHED;
            PG8_LDA(At, 1, 1); PG8_STAGE(PG8_SB(1, 0), b3, voffB); PG8_STAGE(PG8_SB(1, 1), b3 + bhs, voffB); PG8_STAGE(PG8_SA(1, 0), a3, voffA);
            PG8_WAIT_V(8); PG8_WAIT_L(0); PG8_BAR; PG8_MMA(1, 0, At, B0); PG8_MMA(1, 1, At, B1); PG8_BAR; PG8_SCHED;
        }
        if (wr == 0) PG8_BAR;
        E(acc, cur, wr, wc, fr, fq); S.done(cur);
        if (!has_next) break;
#pragma unroll
        for (int a = 0; a < 2; ++a)
#pragma unroll
            for (int b = 0; b < 2; ++b)
#pragma unroll
                for (int m = 0; m < 4; ++m)
#pragma unroll
                    for (int n = 0; n < 2; ++n) acc[a][b][m][n] = (f32x4){0.f, 0.f, 0.f, 0.f};
        cur = nxt; cA = nA; cB = nB; ++ui;
        if (wr == 1) PG8_BAR;
    }
    PG8_WAIT_V(0);
    PG8_BAR;
#undef PG8_SA
#undef PG8_SB
#undef PG8_STAGE
#undef PG8_LDA
#undef PG8_LDB
#undef PG8_MMA
#undef PG8_WAIT_V
#undef PG8_WAIT_L
#undef PG8_BAR
#undef PG8_SCHED
}
template <class Epi, class Sched>
__device__ __forceinline__ void gemm_phase_gather(PG8_LAS unsigned char* lds, const Gemm g, const Sched& S, const Epi& E, const int tid, const int* rowidx) {
    const int wid = __builtin_amdgcn_readfirstlane(tid >> 6), lane = tid & 63, wr = wid >> 2, wc = wid & 3, fr = lane & 15, fq = lane >> 4;
    const int K = g.K, nt = K / BK;
    unsigned voffB[2]; int rowR[2]; unsigned colA[2];
#pragma unroll
    for (int i = 0; i < 2; ++i) { int R, C; stage_rc(tid * 16 + i * 8192, R, C); const int Rb = Epi::PERM ? ((R & ~31) + perm32(R & 31)) : R;
        rowR[i] = R; colA[i] = (unsigned)C * 2u; voffB[i] = (unsigned)(Rb * K + C) * 2u; }
    unsigned ocur[2][2], onxt[2][2], osel[2][2];
#define PG8_GOFF(dst, pm_) do { _Pragma("unroll") for (int _h = 0; _h < 2; ++_h) _Pragma("unroll") for (int _i = 0; _i < 2; ++_i) \
        dst[_h][_i] = (unsigned)rowidx[(pm_) * 256 + _h * 128 + rowR[_i]] * (unsigned)(K * 2) + colA[_i]; } while (0)
    const size_t kstep = (size_t)(BK * 2);
    const size_t hstep = (size_t)HALF * K * 2;
    const size_t tstep = 2 * hstep;
    const unsigned ldsw = (unsigned)wid * 1024u;
    const int aoff = lds_byte(wr * 64 + fr, fq * 8), boff = lds_byte(wc * 32 + fr, fq * 8);
#define PG8_SA(b, h) (((b) * 2 + (h)) * HTB)
#define PG8_SB(b, h) ((4 + (b) * 2 + (h)) * HTB)
#define PG8_STAGE(bufoff, gbase, voff) do { _Pragma("unroll") for (int _i = 0; _i < 2; ++_i) \
        __builtin_amdgcn_global_load_lds((const unsigned*)((const char*)(gbase) + (voff)[_i]), (PG8_LAS unsigned*)(lds + (bufoff) + ldsw + _i * 8192), 16, 0, 0); } while (0)
#define PG8_LDA(dst, b, h) do { _Pragma("unroll") for (int m = 0; m < 4; ++m) _Pragma("unroll") for (int k = 0; k < 2; ++k) dst[m][k] = *(const PG8_LAS bf16x8*)(lds + PG8_SA(b, h) + aoff + m * 2048 + k * 1024); } while (0)
#define PG8_LDB(dst, b, h) do { _Pragma("unroll") for (int n = 0; n < 2; ++n) _Pragma("unroll") for (int k = 0; k < 2; ++k) dst[n][k] = *(const PG8_LAS bf16x8*)(lds + PG8_SB(b, h) + boff + n * 2048 + k * 1024); } while (0)
#define PG8_MMA(ai, bj, At, Bt) do { __builtin_amdgcn_s_setprio(1); _Pragma("unroll") for (int m = 0; m < 4; ++m) _Pragma("unroll") for (int n = 0; n < 2; ++n) _Pragma("unroll") for (int k = 0; k < 2; ++k) \
        acc[ai][bj][m][n] = __builtin_amdgcn_mfma_f32_16x16x32_bf16(Bt[n][k], At[m][k], acc[ai][bj][m][n], 0, 0, 0); __builtin_amdgcn_s_setprio(0); } while (0)
#define PG8_WAIT_V(n) asm volatile("s_waitcnt vmcnt(" #n ")" ::: "memory")
#define PG8_WAIT_L(n) asm volatile("s_waitcnt lgkmcnt(" #n ")" ::: "memory")
#define PG8_BAR __builtin_amdgcn_s_barrier()
#define PG8_SCHED __builtin_amdgcn_sched_barrier(0)
    Unit cur, nxt; int ui = 0;
    if (!S.next(0, cur)) return;
    f32x4 acc[2][2][4][2];
#pragma unroll
    for (int a = 0; a < 2; ++a)
#pragma unroll
        for (int b = 0; b < 2; ++b)
#pragma unroll
            for (int m = 0; m < 4; ++m)
#pragma unroll
                for (int n = 0; n < 2; ++n) acc[a][b][m][n] = (f32x4){0.f, 0.f, 0.f, 0.f};
    bf16x8 At[4][2], B0[2][2], B1[2][2];
    const char* cA = (const char*)g.A; const char* cB = (const char*)g.Bt + (size_t)cur.pn * tstep;
    S.a_ready(cur);
    PG8_GOFF(ocur, cur.pm);
#pragma unroll
    for (int _h = 0; _h < 2; ++_h)
#pragma unroll
        for (int _i = 0; _i < 2; ++_i) onxt[_h][_i] = ocur[_h][_i];
    PG8_STAGE(PG8_SB(0, 0), cB, voffB); PG8_STAGE(PG8_SB(0, 1), cB + hstep, voffB); PG8_STAGE(PG8_SA(0, 0), cA, ocur[0]); PG8_STAGE(PG8_SA(0, 1), cA, ocur[1]);
    if (wr == 1) PG8_BAR;
    PG8_WAIT_V(2); PG8_BAR;
    PG8_STAGE(PG8_SB(1, 0), cB + kstep, voffB); PG8_STAGE(PG8_SA(1, 0), cA + kstep, ocur[0]); PG8_STAGE(PG8_SB(1, 1), cB + hstep + kstep, voffB);
    PG8_WAIT_V(6); PG8_BAR;
    for (;;) {
        const bool has_next = S.next(ui + 1, nxt);
        const char* nA = cA; const char* nB = has_next ? (const char*)g.Bt + (size_t)nxt.pn * tstep : cB;
        if (has_next) PG8_GOFF(onxt, nxt.pm);
        for (int t = 0; t < nt; t += 2) {
            const bool last = (t == nt - 2);
            const char* a1 = cA + (size_t)(t + 1) * kstep;
            const char* a2 = last ? nA : cA + (size_t)(t + 2) * kstep; const char* b2 = last ? nB : cB + (size_t)(t + 2) * kstep;
            const char* a3 = a2 + kstep; const char* b3 = b2 + kstep;
            if (last && has_next) S.a_ready(nxt);
#pragma unroll
            for (int _h = 0; _h < 2; ++_h)
#pragma unroll
                for (int _i = 0; _i < 2; ++_i) osel[_h][_i] = (last && has_next) ? onxt[_h][_i] : ocur[_h][_i];
            PG8_LDB(B0, 0, 0); PG8_LDB(B1, 0, 1); PG8_SCHED; PG8_LDA(At, 0, 0); PG8_STAGE(PG8_SA(1, 1), a1, ocur[1]);
            PG8_WAIT_V(8); PG8_WAIT_L(0); PG8_BAR; PG8_MMA(0, 0, At, B0); PG8_MMA(0, 1, At, B1); PG8_BAR; PG8_SCHED;
            PG8_LDA(At, 0, 1); PG8_STAGE(PG8_SB(0, 0), b2, voffB); PG8_STAGE(PG8_SB(0, 1), b2 + hstep, voffB); PG8_STAGE(PG8_SA(0, 0), a2, osel[0]);
            PG8_WAIT_V(8); PG8_WAIT_L(0); PG8_BAR; PG8_MMA(1, 0, At, B0); PG8_MMA(1, 1, At, B1); PG8_BAR; PG8_SCHED;
            PG8_LDB(B0, 1, 0); PG8_LDB(B1, 1, 1); PG8_SCHED; PG8_LDA(At, 1, 0); PG8_STAGE(PG8_SA(0, 1), a2, osel[1]);
            PG8_WAIT_V(8); PG8_WAIT_L(0); PG8_BAR; PG8_MMA(0, 0, At, B0); PG8_MMA(0, 1, At, B1); PG8_BAR; PG8_SCHED;
            PG8_LDA(At, 1, 1); PG8_STAGE(PG8_SB(1, 0), b3, voffB); PG8_STAGE(PG8_SB(1, 1), b3 + hstep, voffB); PG8_STAGE(PG8_SA(1, 0), a3, osel[0]);
            PG8_WAIT_V(8); PG8_WAIT_L(0); PG8_BAR; PG8_MMA(1, 0, At, B0); PG8_MMA(1, 1, At, B1); PG8_BAR; PG8_SCHED;
        }
        if (wr == 0) PG8_BAR;
        E(acc, cur, wr, wc, fr, fq); S.done(cur);
        if (!has_next) break;
#pragma unroll
        for (int a = 0; a < 2; ++a)
#pragma unroll
            for (int b = 0; b < 2; ++b)
#pragma unroll
                for (int m = 0; m < 4; ++m)
#pragma unroll
                    for (int n = 0; n < 2; ++n) acc[a][b][m][n] = (f32x4){0.f, 0.f, 0.f, 0.f};
        cur = nxt; cB = nB; ++ui;
        if (wr == 1) PG8_BAR;
#pragma unroll
        for (int _h = 0; _h < 2; ++_h)
#pragma unroll
            for (int _i = 0; _i < 2; ++_i) ocur[_h][_i] = onxt[_h][_i];
    }
    PG8_WAIT_V(0);
    PG8_BAR;
#undef PG8_GOFF
#undef PG8_SA
#undef PG8_SB
#undef PG8_STAGE
#undef PG8_LDA
#undef PG8_LDB
#undef PG8_MMA
#undef PG8_WAIT_V
#undef PG8_WAIT_L
#undef PG8_BAR
#undef PG8_SCHED
}
}

#define XB_TMO      128
#define XB_XCNT(j)  (256  + 64 * (j))
#define XB_XSUB(j)  (1280 + 64 * (j))
#define XB_XGEN(j)  (2304 + 64 * (j))
#define XB_TOP      3328
#define XB_TOPGEN   3392
#define XCD_BAR_WORDS 3456
#define XB_SPIN_CAP (1u << 21)
#define LAS __attribute__((address_space(3)))

__device__ __forceinline__ unsigned xb_ld(unsigned* p)              { return __hip_atomic_load(p, __ATOMIC_RELAXED, __HIP_MEMORY_SCOPE_AGENT); }
__device__ __forceinline__ unsigned xb_add(unsigned* p, unsigned v) { return __hip_atomic_fetch_add(p, v, __ATOMIC_RELAXED, __HIP_MEMORY_SCOPE_AGENT); }
__device__ __forceinline__ unsigned xb_xcc_id() { return (unsigned)__builtin_amdgcn_s_getreg((3 << 11) | 20) & 0xFu; }
#define XB_SPIN(cond, bar) do { unsigned _sp = 0; while (cond) { __builtin_amdgcn_s_sleep(1); \
    if ((++_sp & 255u) == 0u) { if (xb_ld(&(bar)[XB_TMO])) break; if (_sp > XB_SPIN_CAP) { atomicAdd(&(bar)[XB_TMO], 1u); break; } } } } while (0)

struct XcdBarrier { unsigned* bar; unsigned x; volatile LAS unsigned* st; };

__device__ __forceinline__ XcdBarrier xcd_barrier_post(unsigned* bar, volatile LAS unsigned* st, bool t0) {
    XcdBarrier b; b.bar = bar; b.x = xb_xcc_id(); b.st = st;
    if (t0) (void)xb_add(&bar[XB_XCNT(b.x)], 1u);
    return b;
}
__device__ __forceinline__ void xcd_barrier_complete(unsigned* bar, unsigned x, unsigned& nloc, unsigned& nx) {
    const unsigned G = gridDim.x * gridDim.y * gridDim.z;
    unsigned sum, cnt, mine, sp = 0u;
    for (;;) {
        sum = 0u; cnt = 0u; mine = 0u;
#pragma unroll
        for (unsigned j = 0; j < 16; ++j) { const unsigned c = xb_ld(&bar[XB_XCNT(j)]); sum += c; cnt += (c > 0u) ? 1u : 0u; mine = (j == x) ? c : mine; }
        if (sum == G) break;
        __builtin_amdgcn_s_sleep(1);
        if ((++sp & 255u) == 0u) { if (xb_ld(&bar[XB_TMO])) break; if (sp > XB_SPIN_CAP) { atomicAdd(&bar[XB_TMO], 1u); break; } }
    }
    nloc = mine > 0u ? mine : 1u; nx = cnt > 0u ? cnt : 1u;
}
__device__ __forceinline__ void xcd_barrier(const XcdBarrier& b, bool t0) {
    asm volatile("s_waitcnt vmcnt(0)" ::: "memory");
    __syncthreads();
    if (t0) {
        unsigned* bar = b.bar;
        __builtin_amdgcn_s_waitcnt(0);
        unsigned nloc = b.st[0], nx = b.st[1];
        if (nloc == 0u) { xcd_barrier_complete(bar, b.x, nloc, nx); b.st[0] = nloc; b.st[1] = nx; }
        const unsigned old = xb_add(&bar[XB_XSUB(b.x)], 1u);
        const unsigned gen = old / nloc;
        if (old + 1u == (gen + 1u) * nloc) {
            __builtin_amdgcn_fence(__ATOMIC_RELEASE, "agent");
            asm volatile("s_waitcnt vmcnt(0)" ::: "memory");
            const unsigned og = xb_add(&bar[XB_TOP], 1u);
            const unsigned tg = og / nx;
            if (og + 1u == (tg + 1u) * nx) xb_add(&bar[XB_TOPGEN], 1u);
            else XB_SPIN(xb_ld(&bar[XB_TOPGEN]) == tg, bar);
            __builtin_amdgcn_fence(__ATOMIC_ACQUIRE, "agent");
            xb_add(&bar[XB_XGEN(b.x)], 1u);
            asm volatile("s_waitcnt vmcnt(0)" ::: "memory");
        } else {
            XB_SPIN(xb_ld(&bar[XB_XGEN(b.x)]) == gen, bar);
            __builtin_amdgcn_fence(__ATOMIC_ACQUIRE, "agent");
            asm volatile("s_waitcnt vmcnt(0)" ::: "memory");
        }
    }
    __syncthreads();
}

typedef unsigned short bf16_t;
typedef float f32x4 __attribute__((ext_vector_type(4)));
typedef unsigned u32x4 __attribute__((ext_vector_type(4)));
typedef unsigned u32x2 __attribute__((ext_vector_type(2)));

constexpr int D = 1024, NB = 16, SEQ = 4096, CTXL = 256, DEPTH = 4;
constexpr int NLAT = NB * SEQ, NCTX = NB * CTXL, NROW = NLAT + NCTX;
constexpr int CONV_CH = 2560, NPROJ = 3616, NPROJ_PAD = 3840;
constexpr int FST = 128;
#define FADDR(R, col) ((((size_t)((col) >> 7)) * NROW + (size_t)(R)) * FST + ((col) & 127))
#define OADDR(R, col) ((((size_t)(R) >> 1) * 32 + ((col) >> 5)) * 64 + ((size_t)(R) & 1) * 32 + ((col) & 31))
constexpr int NMOD = 6 * D;
constexpr size_t MiB = (size_t)1 << 20;
constexpr size_t WS_CTL = 0, WS_ZROW = 65536, WS_MOD = 1 * MiB, WS_CTXR = 3 * MiB, WS_AFF = 19 * MiB, WS_RSTD = 24 * MiB, WS_SELT = 25 * MiB, WS_SELG = 26 * MiB, WS_SLOT = 27 * MiB;
constexpr size_t WS_WIN = 32 * MiB, WS_WOUT = 40 * MiB, WS_WGU = 42 * MiB, WS_WD = 74 * MiB, WS_SM = 90 * MiB;
constexpr size_t WS_F = 100 * MiB, WS_PR = 440 * MiB, WS_OD = 576 * MiB, WS_TQ = 848 * MiB, WS_SCL = 984 * MiB, WS_CB = 995 * MiB, WS_END = 1012 * MiB;
constexpr size_t WS_PC = WS_OD, WS_H = WS_F, WS_MIX = WS_TQ, WS_M = WS_F, WS_H2 = 236 * MiB, WS_HID = WS_PR, WS_YE = WS_OD, WS_XL = WS_TQ;
constexpr int LDS_BYTES = 155648, LDS_XB_OFF = 155392;
constexpr float EPS = 1e-6f;

struct Params {
    const float *x, *c, *ctx, *c_ctx, *ada_w, *ada_b, *norm_g, *w_in, *conv_w, *conv_b, *dn_A_log, *dn_dt_bias, *dn_norm_g, *ssm_A_log, *ssm_dt_bias, *ssm_D, *ssm_norm_g, *w_out, *router_w, *w_gate, *w_up, *w_down;
    float* out; unsigned char* ws;
};

__device__ __forceinline__ float bf2f(unsigned short b) { return __uint_as_float(((unsigned)b) << 16); }
__device__ __forceinline__ unsigned short f2bf(float f) { unsigned u = __float_as_uint(f); u += 0x7FFFu + ((u >> 16) & 1u); return (unsigned short)(u >> 16); }
typedef __bf16 bf16x2_t __attribute__((ext_vector_type(2)));
typedef float f32x2_t __attribute__((ext_vector_type(2)));
__device__ __forceinline__ unsigned pk2(float lo, float hi) { f32x2_t v = {lo, hi}; return __builtin_bit_cast(unsigned, __builtin_convertvector(v, bf16x2_t)); }
__device__ __forceinline__ float lo_bf(unsigned w) { return __uint_as_float(w << 16); }
__device__ __forceinline__ float hi_bf(unsigned w) { return __uint_as_float(w & 0xFFFF0000u); }
__device__ __forceinline__ float silu_f(float t) { return t * __builtin_amdgcn_rcpf(1.f + __expf(-t)); }
__device__ __forceinline__ float sigmoid_f(float t) { return __builtin_amdgcn_rcpf(1.f + __expf(-t)); }
__device__ __forceinline__ float softplus_f(float t) { const float e = __expf(t); return t > 20.f ? t : (t < -10.f ? e : __logf(1.f + e)); }
template <int O> __device__ __forceinline__ float sxor(float v) { return __int_as_float(__builtin_amdgcn_ds_swizzle(__float_as_int(v), 0x1F | (O << 10))); }
template <int O> __device__ __forceinline__ int sxor_i(int v) { return __builtin_amdgcn_ds_swizzle(v, 0x1F | (O << 10)); }
__device__ __forceinline__ float lane_get(float v, int src_lane) { return __int_as_float(__builtin_amdgcn_ds_bpermute(src_lane << 2, __float_as_int(v))); }
__device__ __forceinline__ int lane_get_i(int v, int src_lane) { return __builtin_amdgcn_ds_bpermute(src_lane << 2, v); }
template <int CTRL> __device__ __forceinline__ float dppf(float v) { return __int_as_float(__builtin_amdgcn_update_dpp(0, __float_as_int(v), CTRL, 0xF, 0xF, true)); }
template <int CTRL> __device__ __forceinline__ int dppi(int v) { return __builtin_amdgcn_update_dpp(0, v, CTRL, 0xF, 0xF, true); }
__device__ __forceinline__ float wave_sum(float v, int lane) {
    v += dppf<0xB1>(v); v += dppf<0x4E>(v); v += dppf<0x141>(v); v += dppf<0x140>(v); v += sxor<16>(v); v += lane_get(v, lane ^ 32);
    return v;
}
__device__ __forceinline__ int wave_sum_i(int v, int lane) {
    v += dppi<0xB1>(v); v += dppi<0x4E>(v); v += dppi<0x141>(v); v += dppi<0x140>(v); v += sxor_i<16>(v); v += lane_get_i(v, lane ^ 32);
    return v;
}
__device__ __forceinline__ float wave_incl_scan(float x, int lane) {
#pragma unroll
    for (int o = 1; o < 64; o <<= 1) { const float t = lane_get(x, lane >= o ? lane - o : lane); if (lane >= o) x += t; }
    return x;
}
__device__ __forceinline__ int wave_incl_scan_i(int x, int lane) {
#pragma unroll
    for (int o = 1; o < 64; o <<= 1) { const int t = lane_get_i(x, lane >= o ? lane - o : lane); if (lane >= o) x += t; }
    return x;
}

__device__ __forceinline__ void phase_mods(const Params& p, unsigned char* smem, const int tid, const int bid, const int nblk) {
    float* s_lds = (float*)smem;
    float* red = s_lds + 17 * 1024;
    if (bid >= 192) return;
    for (int i = tid; i < 17 * 1024; i += 512) { const int r = i >> 10, k = i & 1023; const float v = r < 16 ? p.c[r * 1024 + k] : p.c_ctx[k]; s_lds[i] = silu_f(v); }
    __syncthreads();
    float* mod = (float*)(p.ws + WS_MOD);
    for (int it = bid; it < 192; it += nblk) {
        const int l = it / 48, cg = it % 48, jj = tid & 127, kq = tid >> 7, j = cg * 128 + jj;
        float acc[17];
#pragma unroll
        for (int r = 0; r < 17; ++r) acc[r] = 0.f;
        const float* w = p.ada_w + ((size_t)l * 1024 + kq * 256) * NMOD + j;
        const float* sl = s_lds + kq * 256;
#pragma unroll 8
        for (int k = 0; k < 256; ++k) { const float wv = w[(size_t)k * NMOD];
#pragma unroll
            for (int r = 0; r < 17; ++r) acc[r] += sl[r * 1024 + k] * wv; }
#pragma unroll
        for (int r = 0; r < 17; ++r) red[(kq * 17 + r) * 128 + jj] = acc[r];
        __syncthreads();
        for (int i = tid; i < 17 * 128; i += 512) { const int r = i >> 7, j2 = i & 127;
            const float s = red[(0 * 17 + r) * 128 + j2] + red[(1 * 17 + r) * 128 + j2] + red[(2 * 17 + r) * 128 + j2] + red[(3 * 17 + r) * 128 + j2] + p.ada_b[l * NMOD + cg * 128 + j2];
            mod[((size_t)l * 17 + r) * NMOD + cg * 128 + j2] = s; }
        __syncthreads();
    }
}

__device__ __forceinline__ void wconv_item(const float* src, int K, int N, bool real, int k0, int n0, bf16_t* dst, size_t dst_row0, float* scr, int lane) {
    if (real) {
#pragma unroll 8
        for (int i = 0; i < 32; ++i) { const int kk = 2 * i + (lane >> 5); scr[kk * 33 + (lane & 31)] = src[(size_t)(k0 + kk) * N + n0 + (lane & 31)]; }
    }
    asm volatile("s_waitcnt lgkmcnt(0)" ::: "memory");
    const int c = lane & 7;
#pragma unroll
    for (int j = 0; j < 4; ++j) { const int n = (lane >> 3) + 8 * j; const float* q = scr + (8 * c) * 33 + n;
        u32x4 o;
        if (real) { o.x = pk2(q[0 * 33], q[1 * 33]); o.y = pk2(q[2 * 33], q[3 * 33]); o.z = pk2(q[4 * 33], q[5 * 33]); o.w = pk2(q[6 * 33], q[7 * 33]); }
        else { unsigned z = 0u; asm volatile("" : "+v"(z)); o = (u32x4){z, z, z, z}; }
        *(u32x4*)(dst + (dst_row0 + n) * (size_t)K + k0 + 8 * c) = o; }
    asm volatile("s_waitcnt lgkmcnt(0)" ::: "memory");
}
constexpr int WCONV_SPLIT = 4608;
__device__ __forceinline__ void phase_wconv(const Params& p, int l, unsigned char* smem, const int tid, const int bid, const int nblk, const int part, const int wave0) {
    const int lane = tid & 63, wid = __builtin_amdgcn_readfirstlane(tid >> 6), gw = wave0 == -2 ? bid * 6 + wid - 2 : bid * 8 + wid - wave0, NGW = wave0 == -2 ? nblk * 6 : nblk * 8 - wave0;
    if (gw < 0 || (wave0 == -2 && wid < 2)) return;
    float* scr = (float*)(smem + (wave0 == -2 ? 32768 : 0) + (size_t)wid * 8704);
    bf16_t* Win = (bf16_t*)(p.ws + WS_WIN); bf16_t* Wout = (bf16_t*)(p.ws + WS_WOUT); bf16_t* Wgu = (bf16_t*)(p.ws + WS_WGU); bf16_t* Wd = (bf16_t*)(p.ws + WS_WD);
    constexpr int T_IN = 16 * 120, T_OUT = 16 * 32, T_G = 16 * 256, T_U = 16 * 256, T_D = 16 * 256, T_ALL = T_IN + T_OUT + T_G + T_U + T_D;
    const int it_lo = (part == 1 || part == 2) ? T_IN + T_OUT : (part == 3 ? T_IN + T_OUT + WCONV_SPLIT : 0), it_hi = (part == 0) ? T_IN + T_OUT : (part == 2 ? T_IN + T_OUT + WCONV_SPLIT : T_ALL);
    for (int it = it_lo + gw; it < it_hi; it += NGW) {
        int r = it;
        if (r < T_IN) { const int kt = r / 120, nt = r % 120; wconv_item(p.w_in + (size_t)l * D * NPROJ, D, NPROJ, nt * 32 < NPROJ, kt * 64, nt * 32, Win, (size_t)nt * 32, scr, lane); continue; }
        r -= T_IN;
        if (r < T_OUT) { const int kt = r / 32, nt = r % 32; wconv_item(p.w_out + (size_t)l * D * D, D, D, true, kt * 64, nt * 32, Wout, (size_t)nt * 32, scr, lane); continue; }
        r -= T_OUT;
        if (r < T_G + T_U) { const int up = r >= T_G; if (up) r -= T_G; const int e = r / 256, q = r % 256, kt = q / 16, nt = q % 16;
            const float* src = (up ? p.w_up : p.w_gate) + ((size_t)l * 16 + e) * D * 512;
            const int n0 = nt * 32, j = n0 >> 7, cc = n0 & 127;
            wconv_item(src, D, 512, true, kt * 64, n0, Wgu, (size_t)e * 1024 + j * 256 + (up ? 128 : 0) + cc, scr, lane); continue; }
        r -= T_G + T_U;
        { const int e = r / 256, q = r % 256, kt = q / 32, nt = q % 32;
            const float* src = p.w_down + ((size_t)l * 16 + e) * 512 * D;
            wconv_item(src, 512, D, true, kt * 64, nt * 32, Wd, (size_t)e * 1024 + nt * 32, scr, lane); }
    }
}

__device__ __forceinline__ int row_modr(int R) { return R < NLAT ? (R >> 12) : 16; }
__device__ __forceinline__ const float* xres_in(const Params& p, int l, int R) {
    if (l == 0) return R < NLAT ? p.x + (size_t)R * D : p.ctx + (size_t)(R - NLAT) * D;
    return R < NLAT ? p.out + (size_t)R * D : (const float*)(p.ws + WS_CTXR) + (size_t)(R - NLAT) * D;
}
__device__ __forceinline__ bf16_t* xb_ptr(const Params& p, int R) { return R < NLAT ? (bf16_t*)p.out + (size_t)R * D : (bf16_t*)(p.ws + WS_CTXR) + (size_t)(R - NLAT) * D; }
__device__ __forceinline__ bf16_t* xl_ptr(const Params& p, int R) { return (bf16_t*)(p.ws + WS_XL) + (size_t)R * D; }
__device__ __forceinline__ f32x4 unpack4(const u32x2 t) { return (f32x4){lo_bf(t.x), hi_bf(t.x), lo_bf(t.y), hi_bf(t.y)}; }

__device__ __forceinline__ void prenorm_row(const f32x4 (&xv)[4], float rstd, const float* g, const float* shift, const float* scale, bf16_t* hrow, int lane) {
#pragma unroll
    for (int j = 0; j < 4; ++j) { const int i = 256 * j + 4 * lane;
        const f32x4 gv = *(const f32x4*)(g + i), sh = *(const f32x4*)(shift + i), sc = *(const f32x4*)(scale + i);
        const f32x4 h = xv[j] * rstd * gv * (sc + 1.f) + sh;
        u32x2 o; o.x = pk2(h.x, h.y); o.y = pk2(h.z, h.w);
        *(u32x2*)(hrow + i) = o; }
}

__device__ __forceinline__ void phase_h0(const Params& p, const int tid, const int bid, const int nblk) {
    const int lane = tid & 63, gw = bid * 8 + (tid >> 6), NGW = nblk * 8;
    bf16_t* H = (bf16_t*)(p.ws + WS_H); const float* mod = (const float*)(p.ws + WS_MOD);
    for (int R0 = 2 * gw; R0 < NROW; R0 += 2 * NGW) {
        f32x4 xv[2][4];
#pragma unroll
        for (int k = 0; k < 2; ++k) { const float* xr = xres_in(p, 0, R0 + k);
#pragma unroll
            for (int j = 0; j < 4; ++j) xv[k][j] = *(const f32x4*)(xr + 256 * j + 4 * lane); }
#pragma unroll
        for (int k = 0; k < 2; ++k) { const int R = R0 + k; const float* md = mod + (size_t)(0 * 17 + row_modr(R)) * NMOD; float ss = 0.f;
#pragma unroll
            for (int j = 0; j < 4; ++j) ss += xv[k][j].x * xv[k][j].x + xv[k][j].y * xv[k][j].y + xv[k][j].z * xv[k][j].z + xv[k][j].w * xv[k][j].w;
            const float rstd = rsqrtf(wave_sum(ss, lane) * (1.f / D) + EPS);
            prenorm_row(xv[k], rstd, p.norm_g + 0, md + 0, md + D, H + (size_t)R * D, lane); }
    }
}

template <bool NT> __device__ __forceinline__ void store_wide(bf16_t* base, size_t stride, const u32x4 w0, const u32x4 w1, int fr, int fq) {
    const bool hi = (fr & 8) != 0;
    u32x4 X, Y, d1, d2;
    X.x = hi ? w0.x : w1.x; X.y = hi ? w0.y : w1.y; X.z = hi ? w0.z : w1.z; X.w = hi ? w0.w : w1.w;
    Y.x = (unsigned)dppi<0x128>((int)X.x); Y.y = (unsigned)dppi<0x128>((int)X.y); Y.z = (unsigned)dppi<0x128>((int)X.z); Y.w = (unsigned)dppi<0x128>((int)X.w);
    d1.x = hi ? Y.x : w0.x; d1.y = hi ? Y.y : w0.y; d1.z = hi ? Y.z : w0.z; d1.w = hi ? Y.w : w0.w;
    d2.x = hi ? w1.x : Y.x; d2.y = hi ? w1.y : Y.y; d2.z = hi ? w1.z : Y.z; d2.w = hi ? w1.w : Y.w;
    bf16_t* q = base + (size_t)(fr & 7) * stride + (hi ? 32 : 0) + 8 * fq;
    if (NT) { __builtin_nontemporal_store(d1, (u32x4*)q); __builtin_nontemporal_store(d2, (u32x4*)(q + 8 * stride)); }
    else { *(u32x4*)q = d1; *(u32x4*)(q + 8 * stride) = d2; }
}
__device__ __forceinline__ u32x4 pack_acc(const pg8::f32x4 v0, const pg8::f32x4 v1) {
    u32x4 w; w.x = pg8::cvt_pk_bf16(v0[0], v0[1]); w.y = pg8::cvt_pk_bf16(v0[2], v0[3]); w.z = pg8::cvt_pk_bf16(v1[0], v1[1]); w.w = pg8::cvt_pk_bf16(v1[2], v1[3]); return w; }
struct EpiInProj {
    static constexpr bool PERM = true, WIDE = true;
    bf16_t* PC; bf16_t* PR; float* SM;
    __device__ __forceinline__ void operator()(const pg8::f32x4 (&acc)[2][2][4][2], const pg8::Unit& u, int wr, int wc, int fr, int fq) const {
        const int rowb = u.pm * 256 + wr * 64;
        if (u.pn < 14) {
            bf16_t* base; size_t stride;
            if (u.pn < 10) { base = PC + ((size_t)(u.pn >> 1) * NROW) * 512 + (u.pn & 1) * 256 + 64 * wc; stride = 512; }
            else { base = PR + (u.pn - 10) * 256 + 64 * wc; stride = 1024; }
#pragma unroll
            for (int ai = 0; ai < 2; ++ai)
#pragma unroll
                for (int m = 0; m < 4; ++m)
                    store_wide<true>(base + (size_t)(rowb + ai * 128 + m * 16) * stride, stride, pack_acc(acc[ai][0][m][0], acc[ai][0][m][1]), pack_acc(acc[ai][1][m][0], acc[ai][1][m][1]), fr, fq);
        } else if (wc == 0) {
#pragma unroll
            for (int ai = 0; ai < 2; ++ai)
#pragma unroll
                for (int m = 0; m < 4; ++m) { float* d = SM + (size_t)(rowb + ai * 128 + m * 16 + fr) * 32 + 8 * fq; *(pg8::f32x4*)d = acc[ai][0][m][0]; *(pg8::f32x4*)(d + 4) = acc[ai][0][m][1]; }
        }
    }
};
struct EpiPlain {
    static constexpr bool PERM = true, WIDE = true;
    bf16_t* O;
    __device__ __forceinline__ void operator()(const pg8::f32x4 (&acc)[2][2][4][2], const pg8::Unit& u, int wr, int wc, int fr, int fq) const {
        bf16_t* base = O + (size_t)(u.pm * 256 + wr * 64) * 1024 + u.pn * 256 + 64 * wc;
#pragma unroll
        for (int ai = 0; ai < 2; ++ai)
#pragma unroll
            for (int m = 0; m < 4; ++m)
                store_wide<false>(base + (size_t)(ai * 128 + m * 16) * 1024, 1024, pack_acc(acc[ai][0][m][0], acc[ai][0][m][1]), pack_acc(acc[ai][1][m][0], acc[ai][1][m][1]), fr, fq);
    }
};
struct EpiSwiGLU {
    static constexpr bool PERM = true, WIDE = false;
    bf16_t* HID;
    __device__ __forceinline__ void operator()(const pg8::f32x4 (&acc)[2][2][4][2], const pg8::Unit& u, int wr, int wc, int fr, int fq) const {
        const int row0 = u.pm * 256 + wr * 64 + fr, col0 = (u.pn & 3) * 128 + wc * 32 + 8 * fq;
#pragma unroll
        for (int ai = 0; ai < 2; ++ai)
#pragma unroll
            for (int m = 0; m < 4; ++m) { bf16_t* rowp = HID + (size_t)(row0 + ai * 128 + m * 16) * 512 + col0;
                const pg8::f32x4 g0 = acc[ai][0][m][0], g1 = acc[ai][0][m][1], u0 = acc[ai][1][m][0], u1 = acc[ai][1][m][1];
                u32x4 w; w.x = pg8::cvt_pk_bf16(silu_f(g0[0]) * u0[0], silu_f(g0[1]) * u0[1]); w.y = pg8::cvt_pk_bf16(silu_f(g0[2]) * u0[2], silu_f(g0[3]) * u0[3]);
                w.z = pg8::cvt_pk_bf16(silu_f(g1[0]) * u1[0], silu_f(g1[1]) * u1[1]); w.w = pg8::cvt_pk_bf16(silu_f(g1[2]) * u1[2], silu_f(g1[3]) * u1[3]);
                *(u32x4*)rowp = w; }
    }
};
struct EpiDown {
    static constexpr bool PERM = true, WIDE = true;
    bf16_t* YE; const float* gate;
    __device__ __forceinline__ void operator()(const pg8::f32x4 (&acc)[2][2][4][2], const pg8::Unit& u, int wr, int wc, int fr, int fq) const {
        const int rowb = u.pm * 256 + wr * 64; bf16_t* base = YE + (size_t)rowb * 1024 + (u.pn & 3) * 256 + 64 * wc;
#pragma unroll
        for (int ai = 0; ai < 2; ++ai)
#pragma unroll
            for (int m = 0; m < 4; ++m) { const float gt = gate[rowb + ai * 128 + m * 16 + fr];
                store_wide<true>(base + (size_t)(ai * 128 + m * 16) * 1024, 1024, pack_acc(acc[ai][0][m][0] * gt, acc[ai][0][m][1] * gt), pack_acc(acc[ai][1][m][0] * gt, acc[ai][1][m][1] * gt), fr, fq); }
    }
};

typedef short s16x8c __attribute__((ext_vector_type(8)));
typedef __bf16 bf16x8c_t __attribute__((ext_vector_type(8)));
typedef float f32x8c_t __attribute__((ext_vector_type(8)));
__device__ __forceinline__ s16x8c cvt8c(float a0, float a1, float a2, float a3, float a4, float a5, float a6, float a7) {
    f32x8c_t v = {a0, a1, a2, a3, a4, a5, a6, a7}; return __builtin_bit_cast(s16x8c, __builtin_convertvector(v, bf16x8c_t)); }
typedef float f32x2c __attribute__((ext_vector_type(2)));
__device__ __forceinline__ void phase_conv(const Params& p, int l, const int tid, const int bid, const int nblk) {
    const int lane = tid & 63, wid = __builtin_amdgcn_readfirstlane(tid >> 6), gw = bid * 8 + wid, NGW = nblk * 8;
    const bf16_t* PC = (const bf16_t*)(p.ws + WS_PC); bf16_t* F = (bf16_t*)(p.ws + WS_F);
    const int WX = (nblk >> 3) * 8, wx = (bid >> 3) * 8 + wid, xcd = bid & 7; const bool banded = (nblk & 7) == 0;
    const int NFULL = (5440 / NGW) * NGW, NSLOT = NFULL + 3 * (5440 - NFULL);
    for (int rnd = 0; ; ++rnd) {
        const int sl0 = banded ? (rnd * 8 + xcd) * WX + wx : rnd * NGW + gw;
        if (banded ? (rnd * 8 * WX >= NSLOT) : (sl0 >= NSLOT)) break;
        if (sl0 >= NSLOT) continue;
        const int it0 = sl0 < NFULL ? sl0 : NFULL + (sl0 - NFULL) / 3, seg = sl0 < NFULL ? -1 : (sl0 - NFULL) % 3;
        const int cbeg = seg <= 0 ? 0 : (seg == 1 ? 7 : 14), npairs = seg < 0 ? 11 : 4, ofirst = seg <= 0 ? 0 : (seg == 1 ? 22 : 43);
        const int it = 5439 - it0;
        const int cg = it % 5, ri = it / 5, ch = cg * 512 + lane * 8;
        f32x2c w2[4][9], bias2[4];
        { const f32x4* wp = (const f32x4*)(p.conv_w + ((size_t)l * CONV_CH + ch) * 9); float w[72];
#pragma unroll
            for (int i = 0; i < 18; ++i) { const f32x4 t = wp[i]; w[4 * i] = t.x; w[4 * i + 1] = t.y; w[4 * i + 2] = t.z; w[4 * i + 3] = t.w; }
#pragma unroll
            for (int k = 0; k < 4; ++k)
#pragma unroll
                for (int t = 0; t < 9; ++t) w2[k][t] = (f32x2c){w[(2 * k) * 9 + t], w[(2 * k + 1) * 9 + t]};
            const f32x4* bp = (const f32x4*)(p.conv_b + (size_t)l * CONV_CH + ch); const f32x4 b0 = bp[0], b1 = bp[1];
            bias2[0] = (f32x2c){b0.x, b0.y}; bias2[1] = (f32x2c){b0.z, b0.w}; bias2[2] = (f32x2c){b1.x, b1.y}; bias2[3] = (f32x2c){b1.z, b1.w}; }
        long rb0, rb1, rb2; bool v0, v2; int lo, hi, start;
        if (ri < 1024) { const int b = ri >> 6, r = ri & 63; rb1 = (long)b * 4096 + r * 64; v0 = r > 0; v2 = r < 63; rb0 = v0 ? rb1 - 64 : rb1; rb2 = v2 ? rb1 + 64 : rb1; lo = 0; hi = 64; start = 0; }
        else { const int ci = ri - 1024, b = ci >> 2, s = ci & 3; rb1 = (long)NLAT + b * 256; rb0 = rb1; rb2 = rb1; v0 = false; v2 = false; lo = 0; hi = 256; start = s * 64; }
        const bf16_t* PCl = PC + (size_t)cg * NROW * 512 + lane * 8;
        bf16_t* Fl = F + FADDR(0, ch);
        f32x2c a0[4], a1[4], a2[4];
#pragma unroll
        for (int k = 0; k < 4; ++k) { a0[k] = (f32x2c){0.f, 0.f}; a1[k] = a0[k]; a2[k] = a0[k]; }
#define CONV_LOAD(L, CH) do { _Pragma("unroll") for (int q = 0; q < 3; ++q) { const int cc = start - 1 + (CH) * 3 + q; const int ccl = cc < lo ? lo : (cc >= hi ? hi - 1 : cc);        \
                L[q][0] = *(const u32x4*)(PCl + (size_t)(rb0 + ccl) * 512); \
                L[q][1] = *(const u32x4*)(PCl + (size_t)(rb1 + ccl) * 512); \
                L[q][2] = *(const u32x4*)(PCl + (size_t)(rb2 + ccl) * 512); } } while (0)
#define CONV_COL(L, CH, q, P, C, N) do { const int cc = start - 1 + (CH) * 3 + (q); \
                _Pragma("unroll") for (int i = 0; i < 3; ++i) { const u32x4 v = L[q][i]; const unsigned dw[4] = {v.x, v.y, v.z, v.w}; \
                    _Pragma("unroll") for (int k = 0; k < 4; ++k) { const f32x2c x2 = (f32x2c){lo_bf(dw[k]), hi_bf(dw[k])}; \
                        P[k] = __builtin_elementwise_fma(x2, w2[k][i * 3 + 2], P[k]); C[k] = __builtin_elementwise_fma(x2, w2[k][i * 3 + 1], C[k]); \
                        N[k] = __builtin_elementwise_fma(x2, w2[k][i * 3 + 0], i == 0 ? bias2[k] : N[k]); } } \
                const int oc = cc - 1; \
                if (oc >= start + ofirst && oc < start + 64) { \
                    f32x2c uu[4]; \
                    _Pragma("unroll") for (int k = 0; k < 4; ++k) { const f32x2c t = P[k] * -1.4426950408889634f; \
                        const f32x2c den = (f32x2c){__builtin_amdgcn_exp2f(t.x), __builtin_amdgcn_exp2f(t.y)} + 1.f; \
                        uu[k] = P[k] * (f32x2c){__builtin_amdgcn_rcpf(den.x), __builtin_amdgcn_rcpf(den.y)}; } \
                    if (cg < 2) { f32x2c s2 = uu[0] * uu[0]; s2 = __builtin_elementwise_fma(uu[1], uu[1], s2); s2 = __builtin_elementwise_fma(uu[2], uu[2], s2); s2 = __builtin_elementwise_fma(uu[3], uu[3], s2); \
                        float ss = s2.x + s2.y; ss += dppf<0xB1>(ss); ss += dppf<0x4E>(ss); ss += dppf<0x141>(ss); ss += dppf<0x140>(ss); \
                        const float sc = rsqrtf(ss + EPS) * (cg == 0 ? 0.08838834764831845f : 1.f); \
                        _Pragma("unroll") for (int k = 0; k < 4; ++k) uu[k] *= sc; } \
                    *(s16x8c*)(Fl + (size_t)(rb1 + oc) * FST) = cvt8c(uu[0].x, uu[0].y, uu[1].x, uu[1].y, uu[2].x, uu[2].y, uu[3].x, uu[3].y); } } while (0)
#define CONV_CHUNK(L, CH) do { const int c0_ = start - 1 + (CH) * 3; \
            if (!(v0 && v2 && c0_ >= lo && c0_ + 2 < hi)) {            \
                _Pragma("unroll") for (int q = 0; q < 3; ++q) { const int cc = c0_ + q; const bool cv = cc >= lo && cc < hi; const u32x4 z = (u32x4){0u, 0u, 0u, 0u}; \
                    L[q][0] = (cv && v0) ? L[q][0] : z; L[q][1] = cv ? L[q][1] : z; L[q][2] = (cv && v2) ? L[q][2] : z; } } \
            CONV_COL(L, CH, 0, a0, a1, a2); CONV_COL(L, CH, 1, a1, a2, a0); CONV_COL(L, CH, 2, a2, a0, a1); } while (0)
        u32x4 lA[3][3], lB[3][3];
        CONV_LOAD(lA, cbeg);
        for (int cp = 0; cp < npairs; ++cp) {
            CONV_LOAD(lB, cbeg + 2 * cp + 1); __builtin_amdgcn_sched_barrier(0);
            CONV_CHUNK(lA, cbeg + 2 * cp); __builtin_amdgcn_sched_barrier(0);
            if (cp + 1 < npairs) CONV_LOAD(lA, cbeg + 2 * cp + 2);
            __builtin_amdgcn_sched_barrier(0);
            CONV_CHUNK(lB, cbeg + 2 * cp + 1); __builtin_amdgcn_sched_barrier(0);
        }
#undef CONV_LOAD
#undef CONV_COL
#undef CONV_CHUNK
    }
}

__device__ __forceinline__ int scan_row(int b, int d, int s) {
    if (s < CTXL) { const int t = d ? CTXL - 1 - s : s; return NLAT + b * CTXL + t; }
    const int s2 = s - CTXL, t = d ? SEQ - 1 - s2 : s2; return b * SEQ + t;
}
__device__ __forceinline__ void phase_scan_naive(const Params& p, int l, unsigned char* smem, bool ctx_out, const int tid, const int bid) {
    const int lane = tid & 63, c32 = lane & 31, half = lane >> 5;
    const bf16_t* F = (const bf16_t*)(p.ws + WS_F); const float* SM = (const float*)(p.ws + WS_SM); bf16_t* OD = (bf16_t*)(p.ws + WS_OD);
    if (bid < 64) {
        float* sq = (float*)smem; float* sk = sq + 2 * 16 * 128; float* sv = sk + 2 * 16 * 128; float* sb = sv + 2 * 16 * 128; float* sg = sb + 32;
        const int cl = tid >> 8, t = tid & 255, j = (t >> 6) * 32 + c32, chain = bid * 2 + cl, b = chain >> 3, d = (chain >> 2) & 1, hd = chain & 3;
        const float Aexp = __expf(p.dn_A_log[(l * 2 + d) * 4 + hd]), dtb = p.dn_dt_bias[(l * 2 + d) * 4 + hd];
        float S[64];
#pragma unroll
        for (int n = 0; n < 64; ++n) S[n] = 0.f;
        bf16_t* od = OD + (size_t)d * NROW * 1024;
        for (int blk = 0; blk < 272; ++blk) {
            __syncthreads();
            for (int idx = t; idx < 2048; idx += 256) { const int i = idx >> 7, jq = idx & 127; const size_t R = (size_t)scan_row(b, d, blk * 16 + i); const bf16_t* fr = F + FADDR(R, hd * 128 + jq);
                sq[(cl * 16 + i) * 128 + jq] = bf2f(fr[0]); sk[(cl * 16 + i) * 128 + jq] = bf2f(fr[(size_t)4 * NROW * FST]); sv[(cl * 16 + i) * 128 + jq] = bf2f(fr[(size_t)8 * NROW * FST]); }
            if (t < 16) { const size_t R = (size_t)scan_row(b, d, blk * 16 + t);
                sb[cl * 16 + t] = sigmoid_f(SM[R * 32 + d * 4 + hd]); sg[cl * 16 + t] = __expf(-Aexp * softplus_f(SM[R * 32 + 8 + d * 4 + hd] + dtb)); }
            __syncthreads();
            for (int i = 0; i < 16; ++i) {
                const float* kk = sk + (cl * 16 + i) * 128 + half * 64; const float* qq = sq + (cl * 16 + i) * 128 + half * 64;
                const float g = sg[cl * 16 + i], be = sb[cl * 16 + i], v = sv[(cl * 16 + i) * 128 + j];
                float kS = 0.f;
#pragma unroll
                for (int n0 = 0; n0 < 64; n0 += 16) {
#pragma unroll
                    for (int n = n0; n < n0 + 16; ++n) kS += kk[n] * S[n];
                    asm volatile("" ::: "memory"); }
                kS += lane_get(kS, lane ^ 32);
                const float cf = be * (v - g * kS);
                float o = 0.f;
#pragma unroll
                for (int n0 = 0; n0 < 64; n0 += 16) {
#pragma unroll
                    for (int n = n0; n < n0 + 16; ++n) { S[n] = g * S[n] + kk[n] * cf; o += qq[n] * S[n]; }
                    asm volatile("" ::: "memory"); }
                o += lane_get(o, lane ^ 32);
                const int s = blk * 16 + i;
                if (half == 0 && (s >= CTXL || ctx_out)) od[OADDR(scan_row(b, d, s), hd * 128 + j)] = f2bf(o);
            }
        }
    } else if (bid < 128) {
        float* sB = (float*)smem; float* sC = sB + 4 * 8 * 128; float* sx = sC + 4 * 8 * 128; float* sdt = sx + 4 * 8 * 64;
        const int cl = tid >> 7, t = tid & 127, pp = (t >> 6) * 32 + c32, chain = (bid - 64) * 4 + cl, b = chain >> 4, d = (chain >> 3) & 1, head = chain & 7, g = head >> 2;
        const float Aneg = -__expf(p.ssm_A_log[(l * 2 + d) * 8 + head]), dtb = p.ssm_dt_bias[(l * 2 + d) * 8 + head];
        float h[64];
#pragma unroll
        for (int n = 0; n < 64; ++n) h[n] = 0.f;
        bf16_t* od = OD + (size_t)d * NROW * 1024;
        for (int blk = 0; blk < 544; ++blk) {
            __syncthreads();
            for (int idx = t; idx < 1024; idx += 128) { const int i = idx >> 7, n = idx & 127; const size_t R = (size_t)scan_row(b, d, blk * 8 + i);
                sB[(cl * 8 + i) * 128 + n] = bf2f(F[FADDR(R, 2048 + g * 128 + n)]); sC[(cl * 8 + i) * 128 + n] = bf2f(F[FADDR(R, 2304 + g * 128 + n)]); }
            for (int idx = t; idx < 512; idx += 128) { const int i = idx >> 6, q = idx & 63; const size_t R = (size_t)scan_row(b, d, blk * 8 + i);
                sx[(cl * 8 + i) * 64 + q] = bf2f(F[FADDR(R, 1536 + head * 64 + q)]); }
            if (t < 8) { const size_t R = (size_t)scan_row(b, d, blk * 8 + t); sdt[cl * 8 + t] = softplus_f(SM[R * 32 + 16 + d * 8 + head] + dtb); }
            __syncthreads();
            for (int i = 0; i < 8; ++i) {
                const float* bb = sB + (cl * 8 + i) * 128 + half * 64; const float* cc = sC + (cl * 8 + i) * 128 + half * 64;
                const float dt = sdt[cl * 8 + i], dec = __expf(dt * Aneg), xd = sx[(cl * 8 + i) * 64 + pp] * dt;
                float y = 0.f;
#pragma unroll
                for (int n0 = 0; n0 < 64; n0 += 16) {
#pragma unroll
                    for (int n = n0; n < n0 + 16; ++n) { h[n] = dec * h[n] + bb[n] * xd; y += cc[n] * h[n]; }
                    asm volatile("" ::: "memory"); }
                y += lane_get(y, lane ^ 32);
                const int s = blk * 8 + i;
                if (half == 0 && (s >= CTXL || ctx_out)) od[OADDR(scan_row(b, d, s), 512 + head * 64 + pp)] = f2bf(y);
            }
        }
    }
}

typedef short s16x8 __attribute__((ext_vector_type(8)));
typedef __bf16 bf16x8_t __attribute__((ext_vector_type(8)));
typedef float f32x8_t __attribute__((ext_vector_type(8)));
typedef float f32x16 __attribute__((ext_vector_type(16)));
typedef __bf16 bf16x16_t __attribute__((ext_vector_type(16)));
typedef short s16x16 __attribute__((ext_vector_type(16)));
#define MFMA32(a, b, c) __builtin_amdgcn_mfma_f32_32x32x16_bf16((a), (b), (c), 0, 0, 0)
__device__ __forceinline__ s16x8 cvt8(float a0, float a1, float a2, float a3, float a4, float a5, float a6, float a7) {
    f32x8_t v = {a0, a1, a2, a3, a4, a5, a6, a7}; return __builtin_bit_cast(s16x8, __builtin_convertvector(v, bf16x8_t)); }
#define PACK_STEP(x, sp) cvt8((x)[8 * (sp) + 0], (x)[8 * (sp) + 1], (x)[8 * (sp) + 2], (x)[8 * (sp) + 3], (x)[8 * (sp) + 4], (x)[8 * (sp) + 5], (x)[8 * (sp) + 6], (x)[8 * (sp) + 7])
__device__ __forceinline__ f32x16 zero16() { f32x16 z;
#pragma unroll
    for (int i = 0; i < 16; ++i) z[i] = 0.f;
    return z; }
__device__ __forceinline__ size_t chunk_row0(int b, int cidx) { return cidx < 4 ? (size_t)NLAT + b * CTXL + cidx * 64 : (size_t)b * SEQ + (cidx - 4) * 64; }
constexpr int SCL_FLOATS = 320;
constexpr int N_DNITEMS = NB * 68 * 4 * 2, N_SSDITEMS = NB * 68 * 2;

__device__ __forceinline__ void prep_dn_item(const Params& p, int l, int item2, float* At, float* Gs, float* Bs) {
    const int item = item2 >> 1, dsel = item2 & 1;
    int lane = __builtin_amdgcn_mbcnt_hi(~0u, __builtin_amdgcn_mbcnt_lo(~0u, 0u)); asm volatile("" : "+v"(lane));
    const int hd = item & 3, bc = item >> 2, cidx = bc % 68, b = bc / 68, r = lane & 31, h = lane >> 5;
    const size_t R0 = chunk_row0(b, cidx);
    const bf16_t* F = (const bf16_t*)(p.ws + WS_F); const float* SM = (const float*)(p.ws + WS_SM);
    const bf16_t* Fk = F + FADDR(R0, 512 + hd * 128); const bf16_t* Fq = F + FADDR(R0, hd * 128);
    unsigned char* tq = p.ws + WS_TQ + (size_t)item * 2 * 16384;
    float* scl = (float*)(p.ws + WS_SCL) + (size_t)item * 2 * SCL_FLOATS;
    { const int d = dsel;
        const int tok = d ? 63 - lane : lane;
        const float dnb = SM[(R0 + tok) * 32 + d * 4 + hd], dna = SM[(R0 + tok) * 32 + 8 + d * 4 + hd];
        const float be = sigmoid_f(dnb), lg = -__expf(p.dn_A_log[(l * 2 + d) * 4 + hd]) * softplus_f(dna + p.dn_dt_bias[(l * 2 + d) * 4 + hd]);
        const float x = wave_incl_scan(lg, lane);
        const float Gl = lane_get(x, 63);
        Gs[d * 64 + tok] = x; Bs[d * 64 + tok] = be;
        float* sc = scl + d * SCL_FLOATS; const float eg = __expf(x);
        sc[tok] = be; sc[64 + tok] = be * eg; sc[128 + tok] = eg; sc[192 + tok] = __expf(Gl - x); if (lane == 0) sc[256] = __expf(Gl);
    }
    { const int d = dsel;
        asm volatile("" ::: "memory");
        {   s16x8 kf[2][8];
#pragma unroll
            for (int mt = 0; mt < 2; ++mt)
#pragma unroll
                for (int s = 0; s < 8; ++s) kf[mt][s] = *(const s16x8*)(Fk + (size_t)(32 * mt + r) * FST + 16 * s + 8 * h);
#pragma unroll
            for (int bt = 0; bt < 2; ++bt) { const int x = 32 * bt + r; const float gx = Gs[d * 64 + x], bx = Bs[d * 64 + x]; const int ox = d ? 63 - x : x;
#pragma unroll
                for (int at = 0; at < 2; ++at) { f32x16 kk = zero16();
#pragma unroll
                    for (int s = 0; s < 8; ++s) kk = MFMA32(kf[at][s], kf[bt][s], kk);
#pragma unroll
                    for (int q4 = 0; q4 < 4; ++q4) { const int y0 = 32 * at + 8 * q4 + 4 * h; const f32x4 gy = *(const f32x4*)(Gs + d * 64 + y0);
#pragma unroll
                        for (int e = 0; e < 4; ++e) { const int y = y0 + e; const bool valid = d ? (y > x) : (y < x);
                            const float val = valid ? bx * kk[4 * q4 + e] * __expf(gx - gy[e]) : 0.f;
                            At[(d ? 63 - y : y) * 64 + ox] = val; } } } }
            asm volatile("" ::: "memory");
    #pragma unroll
            for (int it = 0; it < 2; ++it) { const int i = 32 * it + r; s16x8 qf[8];
    #pragma unroll
                for (int s = 0; s < 8; ++s) qf[s] = *(const s16x8*)(Fq + (size_t)i * FST + 16 * s + 8 * h);
    #pragma unroll
                for (int jt = 0; jt < 2; ++jt) { f32x16 x = zero16();
    #pragma unroll
                    for (int s = 0; s < 8; ++s) x = MFMA32(kf[jt][s], qf[s], x);
                    { const int d = dsel; const float gi = Gs[d * 64 + i]; float v[16];
    #pragma unroll
                        for (int q4 = 0; q4 < 4; ++q4) { const int j0 = 32 * jt + 8 * q4 + 4 * h; const f32x4 gj = *(const f32x4*)(Gs + d * 64 + j0);
    #pragma unroll
                            for (int e = 0; e < 4; ++e) { const int j = j0 + e; const bool valid = d ? (j >= i) : (j <= i); v[4 * q4 + e] = valid ? x[4 * q4 + e] * __expf(gi - gj[e]) : 0.f; } }
                        unsigned char* qkf = tq + (size_t)d * 16384 + 8192;
    #pragma unroll
                        for (int sp = 0; sp < 2; ++sp)
                            *(s16x8*)(qkf + (size_t)(((it * 4 + 2 * jt + sp) * 64) + lane) * 16) = cvt8(v[8 * sp], v[8 * sp + 1], v[8 * sp + 2], v[8 * sp + 3], v[8 * sp + 4], v[8 * sp + 5], v[8 * sp + 6], v[8 * sp + 7]); } } }

        }
        asm volatile("" ::: "memory");
#if PREP_OLD
        float Tt[64]; int Ac[64];
#pragma unroll
        for (int i = 0; i < 64; ++i) Ac[i] = __float_as_int(At[i * 64 + lane]);
        asm volatile("" ::: "memory");
        Tt[63] = (lane == 63) ? 1.f : 0.f;
#pragma unroll
        for (int i = 62; i >= PROBE_SUBST_LO; --i) { float acc = (lane == i) ? 1.f : 0.f;
#pragma unroll
            for (int j = i + 1; j < 64; ++j) acc -= __int_as_float(__builtin_amdgcn_readlane(Ac[i], j)) * Tt[j];
            Tt[i] = acc; }
#else
        float Tt[64];
        {   const int hL = lane >> 5, cL = lane & 31;
            float TB[32];
            {   int AcS[31];
#pragma unroll
                for (int i = 0; i < 31; ++i) AcS[i] = __float_as_int(At[(32 * hL + i) * 64 + lane]);
                asm volatile("" ::: "memory");
#pragma unroll
                for (int i = 0; i < 31; ++i) TB[i] = 0.f;
                TB[31] = (cL == 31) ? 1.f : 0.f;
#pragma unroll
                for (int pass = 0; pass < 2; ++pass) {
#pragma unroll
                    for (int i = 30; i >= 0; --i) { float acc = (cL == i) ? 1.f : 0.f;
#pragma unroll
                        for (int j = i + 1; j < 32; ++j) acc -= __int_as_float(__builtin_amdgcn_readlane(AcS[i], 32 * pass + j)) * TB[j];
                        TB[i] = (hL == pass) ? acc : TB[i]; }
                }
            }
            {   float* Q = At + (hL ? 32 * 64 + 32 : 0);
#pragma unroll
                for (int jj = 0; jj < 32; ++jj) Q[cL * 64 + (jj ^ cL)] = TB[jj]; }
            asm volatile("" ::: "memory");
            f32x16 P = zero16();
#pragma unroll
            for (int s2 = 0; s2 < 16; ++s2) { const int kk = 2 * s2 + hL; const float av = At[kk * 64 + 32 + cL], bv = At[kk * 64 + (cL ^ kk)]; P = __builtin_amdgcn_mfma_f32_32x32x2f32(av, bv, P, 0, 0, 0); }
            f32x16 Dm = zero16();
#pragma unroll
            for (int s2 = 0; s2 < 16; ++s2) { const int kk = (s2 & 3) + 8 * (s2 >> 2) + 4 * hL; const float av = At[(32 + cL) * 64 + 32 + (kk ^ cL)]; Dm = __builtin_amdgcn_mfma_f32_32x32x2f32(av, P[s2], Dm, 0, 0, 0); }
            asm volatile("" ::: "memory");
#pragma unroll
            for (int reg = 0; reg < 16; ++reg) { const int row = (reg & 3) + 8 * (reg >> 2) + 4 * hL; At[row * 64 + 32 + (cL ^ row)] = -Dm[reg]; }
            asm volatile("" ::: "memory");
#pragma unroll
            for (int jj = 0; jj < 32; ++jj) { const float t21 = At[cL * 64 + 32 + (jj ^ cL)];
                Tt[jj] = hL ? t21 : TB[jj]; Tt[32 + jj] = hL ? TB[jj] : 0.f; }
            asm volatile("" ::: "memory");
        }
#endif
        const int gam = d ? 63 - lane : lane; unsigned char* tf = tq + (size_t)d * 16384;
#pragma unroll
        for (int s = 0; s < 4; ++s)
#pragma unroll
            for (int hh = 0; hh < 2; ++hh) { float v[8];
#pragma unroll
                for (int jj = 0; jj < 8; ++jj) { const int rho = 16 * s + 8 * (jj >> 2) + 4 * hh + (jj & 3); v[jj] = d ? Tt[63 - rho] : Tt[rho]; }
                *(s16x8*)(tf + (size_t)((((gam >> 5) * 4 + s) * 64) + (gam & 31) + 32 * hh) * 16) = cvt8(v[0], v[1], v[2], v[3], v[4], v[5], v[6], v[7]); }
    }
    asm volatile("" ::: "memory");
    asm volatile("" ::: "memory");
}
__device__ __forceinline__ void prep_ssd_item(const Params& p, int item) {
    int lane = __builtin_amdgcn_mbcnt_hi(~0u, __builtin_amdgcn_mbcnt_lo(~0u, 0u)); asm volatile("" : "+v"(lane));
    const int g = item & 1, bc = item >> 1, cidx = bc % 68, b = bc / 68, r = lane & 31, h = lane >> 5;
    const size_t R0 = chunk_row0(b, cidx);
    const bf16_t* F = (const bf16_t*)(p.ws + WS_F); const bf16_t* FB = F + FADDR(R0, 2048 + g * 128); const bf16_t* FC = F + FADDR(R0, 2304 + g * 128);
    unsigned char* cb = p.ws + WS_CB + (size_t)item * 8192;
    s16x8 bf[2][8], cf[2][8];
#pragma unroll
    for (int mt = 0; mt < 2; ++mt)
#pragma unroll
        for (int s = 0; s < 8; ++s) { bf[mt][s] = *(const s16x8*)(FB + (size_t)(32 * mt + r) * FST + 16 * s + 8 * h); cf[mt][s] = *(const s16x8*)(FC + (size_t)(32 * mt + r) * FST + 16 * s + 8 * h); }
#pragma unroll
    for (int jt = 0; jt < 2; ++jt)
#pragma unroll
        for (int it = 0; it < 2; ++it) { f32x16 acc = zero16();
#pragma unroll
            for (int s = 0; s < 8; ++s) acc = MFMA32(bf[jt][s], cf[it][s], acc);
#pragma unroll
            for (int sp = 0; sp < 2; ++sp) *(s16x8*)(cb + (size_t)(((it * 4 + 2 * jt + sp) * 64) + lane) * 16) = PACK_STEP(acc, sp); }
}
__device__ __forceinline__ void phase_prep(const Params& p, int l, unsigned char* smem, const int tid, const int bid, const int nblk) {
    const int wid = __builtin_amdgcn_readfirstlane(tid >> 6), gw = bid * 8 + wid, NGW = nblk * 8;
    float* At = (float*)(smem + (size_t)wid * 17408); float* Gs = At + 4096; float* Bs = Gs + 128;
    if (nblk == 256) {
        for (int k = 0; k < 4; ++k) prep_dn_item(p, l, k * NGW + gw, At, Gs, Bs);
        if (wid < 2) prep_dn_item(p, l, 4 * NGW + wid * 256 + bid, At, Gs, Bs);
        prep_ssd_item(p, gw);
        if (wid == 4 && bid < N_SSDITEMS - 2048) prep_ssd_item(p, 2048 + bid);
    } else {
        for (int it = gw; it < N_DNITEMS; it += NGW) prep_dn_item(p, l, it, At, Gs, Bs);
        for (int it = NGW - 1 - gw; it < N_SSDITEMS; it += NGW) prep_ssd_item(p, it);
    }
}

struct StagePerm { u32x4 c0[2], c1[2]; };
__device__ __forceinline__ void stage_perm_load(StagePerm& t, const bf16_t* src, int hw, int lane) {
#pragma unroll
    for (int ps = 0; ps < 2; ++ps) { const int row = 16 * hw + 8 * ps + (lane >> 3), s = lane & 7; const bf16_t* q = src + (size_t)row * FST + 16 * s;
        t.c0[ps] = *(const u32x4*)q; t.c1[ps] = *(const u32x4*)(q + 8); }
}
__device__ __forceinline__ void stage_perm_store(const StagePerm& t, unsigned char* dst, int hw, int lane) {
#pragma unroll
    for (int ps = 0; ps < 2; ++ps) { const int row = 16 * hw + 8 * ps + (lane >> 3), s = lane & 7, mt = row >> 5, rr = row & 31;
        *(u32x4*)(dst + ((mt * 8 + s) * 64 + rr) * 16) = (u32x4){t.c0[ps].x, t.c0[ps].y, t.c1[ps].x, t.c1[ps].y};
        *(u32x4*)(dst + ((mt * 8 + s) * 64 + rr + 32) * 16) = (u32x4){t.c0[ps].z, t.c0[ps].w, t.c1[ps].z, t.c1[ps].w}; }
}
struct StageT { unsigned short v[4][8]; };
__device__ __forceinline__ void stage_t_load(StageT& t, const bf16_t* src, int hw, int lane) {
    const int r = lane & 31, h = lane >> 5;
#pragma unroll
    for (int s = 0; s < 4; ++s)
#pragma unroll
        for (int jj = 0; jj < 8; ++jj) t.v[s][jj] = src[(size_t)(16 * s + 8 * (jj >> 2) + 4 * h + (jj & 3)) * FST + 32 * hw + r];
}
__device__ __forceinline__ void stage_t_store(const StageT& t, unsigned char* dst, int hw, int lane) {
#pragma unroll
    for (int s = 0; s < 4; ++s) { u32x4 w; w.x = (unsigned)t.v[s][0] | ((unsigned)t.v[s][1] << 16); w.y = (unsigned)t.v[s][2] | ((unsigned)t.v[s][3] << 16);
        w.z = (unsigned)t.v[s][4] | ((unsigned)t.v[s][5] << 16); w.w = (unsigned)t.v[s][6] | ((unsigned)t.v[s][7] << 16);
        *(u32x4*)(dst + ((hw * 4 + s) * 64 + lane) * 16) = w; }
}
__device__ __forceinline__ void gather_cols(s16x8 (&f)[4], const bf16_t* src_col, int h) {
#pragma unroll
    for (int s = 0; s < 4; ++s)
#pragma unroll
        for (int jj = 0; jj < 8; ++jj) f[s][jj] = (short)src_col[(size_t)(16 * s + 8 * (jj >> 2) + 4 * h + (jj & 3)) * FST];
}
__device__ __forceinline__ void rows_load(u32x4 (&v)[4], const bf16_t* src_row0, int lane) {
#pragma unroll
    for (int q = 0; q < 4; ++q) v[q] = *(const u32x4*)(src_row0 + (size_t)lane * FST + 8 * q);
}
__device__ __forceinline__ void rows_park(const u32x4 (&v)[4], unsigned char* img, int lane) {
#pragma unroll
    for (int q = 0; q < 4; ++q) *(u32x4*)(img + lane * 80 + 16 * q) = v[q];
}
__device__ __forceinline__ void frags_from_img(s16x8 (&f)[4], const unsigned char* img, int r, int h) {
#pragma unroll
    for (int s = 0; s < 4; ++s)
#pragma unroll
        for (int jj = 0; jj < 8; ++jj) f[s][jj] = (short)*(const unsigned short*)(img + (16 * s + 8 * (jj >> 2) + 4 * h + (jj & 3)) * 80 + 2 * r);
}
__device__ __forceinline__ int scan_chunk(int d, int step) { return d == 0 ? step : (step < 4 ? 3 - step : 71 - step); }

constexpr int DNB_QA = 16384, DNB_KT = 32768, DNB_T = 49152, DNB_QK = 57344, DNB_SC = 65536, DNB_BYTES = 66816 + 256, DN_IMG = 2 * DNB_BYTES, IMG_BYTES = 5120;
struct Band { u32x4 c[2][2]; };
__device__ __forceinline__ void band_load(Band& t, const bf16_t* src, int hw, int lane) {
#pragma unroll
    for (int sl = 0; sl < 2; ++sl) { const bf16_t* q = src + (size_t)lane * FST + 16 * (2 * hw + sl); t.c[sl][0] = *(const u32x4*)q; t.c[sl][1] = *(const u32x4*)(q + 8); }
}
__device__ __forceinline__ void band_store_perm(const Band& t, unsigned char* dst, int hw, int lane) {
    const int mt = lane >> 5, rr = lane & 31;
#pragma unroll
    for (int sl = 0; sl < 2; ++sl) { const int s = 2 * hw + sl;
        *(u32x4*)(dst + ((mt * 8 + s) * 64 + rr) * 16) = (u32x4){t.c[sl][0].x, t.c[sl][0].y, t.c[sl][1].x, t.c[sl][1].y};
        *(u32x4*)(dst + ((mt * 8 + s) * 64 + rr + 32) * 16) = (u32x4){t.c[sl][0].z, t.c[sl][0].w, t.c[sl][1].z, t.c[sl][1].w}; }
}
__device__ __forceinline__ void band_store_transposed(const unsigned char* perm, unsigned char* dst, int hw, int lane) {
    const int r = lane & 31, h = lane >> 5;
    const unsigned char* base = perm + (size_t)((2 * hw + (r >> 4)) * 64 + 32 * ((r >> 2) & 1)) * 16 + 2 * (4 * ((r >> 3) & 1) + (r & 3));
#pragma unroll
    for (int s2 = 0; s2 < 4; ++s2) { unsigned short v[8];
#pragma unroll
        for (int jj = 0; jj < 8; ++jj) { const int tok = 16 * s2 + 8 * (jj >> 2) + 4 * h + (jj & 3);
            v[jj] = *(const unsigned short*)(base + (size_t)(((s2 >> 1) * 8) * 64 + (tok & 31)) * 16); }
        u32x4 w; w.x = (unsigned)v[0] | ((unsigned)v[1] << 16); w.y = (unsigned)v[2] | ((unsigned)v[3] << 16); w.z = (unsigned)v[4] | ((unsigned)v[5] << 16); w.w = (unsigned)v[6] | ((unsigned)v[7] << 16);
        *(u32x4*)(dst + ((hw * 4 + s2) * 64 + lane) * 16) = w; }
}
struct DnStage { Band bk, bq; u32x4 cp[5]; };
__device__ __forceinline__ void dn_stage_load(DnStage& g, const Params& p, int b, int d, int hd, int cidx, int hw, int lane) {
    asm volatile("" : "+s"(hw));
    const bf16_t* F = (const bf16_t*)(p.ws + WS_F); const size_t R0 = chunk_row0(b, cidx);
    const bf16_t* Fq = F + FADDR(R0, hd * 128); const bf16_t* Fk = F + FADDR(R0, 512 + hd * 128);
    const size_t item = ((size_t)(b * 68 + cidx) * 4 + hd);
    const unsigned char* tq = p.ws + WS_TQ + (item * 2 + d) * 16384; const unsigned char* sc = (const unsigned char*)((const float*)(p.ws + WS_SCL) + (item * 2 + d) * SCL_FLOATS);
    band_load(g.bk, Fk, hw, lane); band_load(g.bq, Fq, hw, lane);
    const int t256 = hw * 64 + lane;
#pragma unroll
    for (int i = 0; i < 4; ++i) g.cp[i] = *(const u32x4*)(tq + (size_t)(i * 256 + t256) * 16);
    g.cp[4] = *(const u32x4*)(sc + (t256 < 80 ? t256 : 0) * 16);
}
__device__ __forceinline__ void dn_stage_store(const DnStage& g, unsigned char* buf, int hw, int lane) {
    asm volatile("" : "+s"(hw));
    const int t256 = hw * 64 + lane;
    band_store_perm(g.bk, buf, hw, lane); band_store_perm(g.bq, buf + DNB_QA, hw, lane); band_store_transposed(buf, buf + DNB_KT, hw, lane);
#pragma unroll
    for (int i = 0; i < 4; ++i) *(u32x4*)(buf + DNB_T + (i * 256 + t256) * 16) = g.cp[i];
    if (t256 < 80) *(u32x4*)(buf + DNB_SC + t256 * 16) = g.cp[4];
}
__device__ __forceinline__ void dn_scan_chain(const Params& p, int chain, unsigned char* smem, bool ctx_out, int wid) {
    const int b = chain >> 3, d = (chain >> 2) & 1, hd = chain & 3;
    int lane = __builtin_amdgcn_mbcnt_hi(~0u, __builtin_amdgcn_mbcnt_lo(~0u, 0u)); asm volatile("" : "+v"(lane)); int r = lane & 31, h = lane >> 5;
    const bf16_t* F = (const bf16_t*)(p.ws + WS_F); bf16_t* od = (bf16_t*)(p.ws + WS_OD) + (size_t)d * NROW * 1024;
    if (wid >= 4) {
        DnStage g;
        dn_stage_load(g, p, b, d, hd, scan_chunk(d, 0), wid - 4, lane); dn_stage_store(g, smem, wid - 4, lane);
        dn_stage_load(g, p, b, d, hd, scan_chunk(d, 1), wid - 4, lane);
        __syncthreads();
        for (int step = 0; step < 68; ++step) {
            lane = __builtin_amdgcn_mbcnt_hi(~0u, __builtin_amdgcn_mbcnt_lo(~0u, 0u)); asm volatile("" : "+v"(lane));
            if (step + 1 < 68) dn_stage_store(g, smem + ((step + 1) & 1) * DNB_BYTES, wid - 4, lane);
            if (step + 2 < 68) dn_stage_load(g, p, b, d, hd, scan_chunk(d, step + 2), wid - 4, lane);
            __syncthreads();
        }
        return;
    }
    __builtin_amdgcn_s_setprio(2);
    f32x16 S[4];
#pragma unroll
    for (int i = 0; i < 4; ++i) S[i] = zero16();
    u32x4 vrow[4];
    const int vcol0 = 1024 + hd * 128 + 32 * (wid & 3);
    unsigned char* img = smem + DN_IMG + (wid & 3) * IMG_BYTES;
    if (wid < 4) rows_load(vrow, F + FADDR(chunk_row0(b, scan_chunk(d, 0)), vcol0), lane);
    bool pwr = false; size_t pR0 = 0;
    __syncthreads();
    for (int step = 0; step < 68; ++step) {
        lane = __builtin_amdgcn_mbcnt_hi(~0u, __builtin_amdgcn_mbcnt_lo(~0u, 0u)); asm volatile("" : "+v"(lane)); r = lane & 31; h = lane >> 5;
        unsigned char* buf = smem + (step & 1) * DNB_BYTES;
        {
            const int cidx = scan_chunk(d, step); const size_t R0 = chunk_row0(b, cidx);
            u32x4 orow[4];
#pragma unroll
            for (int q = 0; q < 4; ++q) orow[q] = *(const u32x4*)(img + (16 * q + (lane >> 2)) * 80 + 16 * (lane & 3));
            rows_park(vrow, img, lane);
            if (step > 0 && pwr) { bf16_t* op = od + OADDR(pR0 + (lane >> 2), hd * 128 + 32 * (wid & 3) + 8 * (lane & 3));
#pragma unroll
                for (int q = 0; q < 4; ++q) *(u32x4*)(op + (size_t)q * 8 * 2048) = orow[q]; }
            if (step + 1 < 68) rows_load(vrow, F + FADDR(chunk_row0(b, scan_chunk(d, step + 1)), vcol0), lane);
            const float* sc = (const float*)(buf + DNB_SC);
#define SCHED_FENCE() __builtin_amdgcn_sched_barrier(0)
            s16x8 Rb[4];
            {   f32x16 a0 = zero16(), a1 = zero16();
#pragma unroll
                for (int hf = 0; hf < 2; ++hf) { s16x8 fk[8];
#pragma unroll
                    for (int i = 0; i < 4; ++i) { fk[i] = *(const s16x8*)(buf + ((4 * hf + i) * 64 + lane) * 16); fk[4 + i] = *(const s16x8*)(buf + ((8 + 4 * hf + i) * 64 + lane) * 16); }
                    SCHED_FENCE();
#pragma unroll
                    for (int i = 0; i < 4; ++i) { const int s = 4 * hf + i; const s16x8 sb = PACK_STEP(S[s >> 1], s & 1); a0 = MFMA32(fk[i], sb, a0); a1 = MFMA32(fk[4 + i], sb, a1); }
                    SCHED_FENCE(); }
                s16x8 vf[4];
                frags_from_img(vf, img, r, h);
#pragma unroll
                for (int t = 0; t < 2; ++t)
#pragma unroll
                    for (int sp = 0; sp < 2; ++sp) { float v[8];
#pragma unroll
                        for (int q4 = 0; q4 < 2; ++q4) { const int i0 = 32 * t + 16 * sp + 8 * q4 + 4 * h; const f32x4 be = *(const f32x4*)(sc + i0), bg = *(const f32x4*)(sc + 64 + i0);
#pragma unroll
                            for (int e = 0; e < 4; ++e) v[4 * q4 + e] = be[e] * bf2f((unsigned short)vf[2 * t + sp][4 * q4 + e]) - bg[e] * (t == 0 ? a0[8 * sp + 4 * q4 + e] : a1[8 * sp + 4 * q4 + e]); }
                        Rb[2 * t + sp] = cvt8(v[0], v[1], v[2], v[3], v[4], v[5], v[6], v[7]); }
            }
            s16x8 Vb[4], Vw[4];
            {   s16x8 ft[8];
#pragma unroll
                for (int i = 0; i < 8; ++i) ft[i] = *(const s16x8*)(buf + DNB_T + (i * 64 + lane) * 16);
                SCHED_FENCE();
                f32x16 vn0 = zero16(), vn1 = zero16();
#pragma unroll
                for (int s = 0; s < 4; ++s) { vn0 = MFMA32(ft[s], Rb[s], vn0); vn1 = MFMA32(ft[4 + s], Rb[s], vn1); }
                SCHED_FENCE();
#pragma unroll
                for (int t = 0; t < 2; ++t)
#pragma unroll
                    for (int sp = 0; sp < 2; ++sp) { float v[8];
#pragma unroll
                        for (int q4 = 0; q4 < 2; ++q4) { const int i0 = 32 * t + 16 * sp + 8 * q4 + 4 * h; const f32x4 el = *(const f32x4*)(sc + 192 + i0);
#pragma unroll
                            for (int e = 0; e < 4; ++e) v[4 * q4 + e] = el[e] * (t == 0 ? vn0[8 * sp + 4 * q4 + e] : vn1[8 * sp + 4 * q4 + e]); }
                        Vb[2 * t + sp] = (t == 0) ? PACK_STEP(vn0, sp) : PACK_STEP(vn1, sp); Vw[2 * t + sp] = cvt8(v[0], v[1], v[2], v[3], v[4], v[5], v[6], v[7]); }
            }
            const bool wr = (cidx >= 4) || ctx_out;
            {   f32x16 o0 = zero16(), o1 = zero16();
#pragma unroll
                for (int hf = 0; hf < 2; ++hf) { s16x8 fq[8];
#pragma unroll
                    for (int i = 0; i < 4; ++i) { fq[i] = *(const s16x8*)(buf + DNB_QA + ((4 * hf + i) * 64 + lane) * 16); fq[4 + i] = *(const s16x8*)(buf + DNB_QA + ((8 + 4 * hf + i) * 64 + lane) * 16); }
                    SCHED_FENCE();
#pragma unroll
                    for (int i = 0; i < 4; ++i) { const int s = 4 * hf + i; const s16x8 sb = PACK_STEP(S[s >> 1], s & 1); o0 = MFMA32(fq[i], sb, o0); o1 = MFMA32(fq[4 + i], sb, o1); }
                    SCHED_FENCE(); }
                s16x8 fqk[8];
#pragma unroll
                for (int i = 0; i < 8; ++i) fqk[i] = *(const s16x8*)(buf + DNB_QK + (i * 64 + lane) * 16);
#pragma unroll
                for (int q4 = 0; q4 < 4; ++q4) { const f32x4 eg0 = *(const f32x4*)(sc + 128 + 8 * q4 + 4 * h), eg1 = *(const f32x4*)(sc + 128 + 32 + 8 * q4 + 4 * h);
#pragma unroll
                    for (int e = 0; e < 4; ++e) { o0[4 * q4 + e] *= eg0[e]; o1[4 * q4 + e] *= eg1[e]; } }
                SCHED_FENCE();
#pragma unroll
                for (int s = 0; s < 4; ++s) { o0 = MFMA32(fqk[s], Vb[s], o0); o1 = MFMA32(fqk[4 + s], Vb[s], o1); }
                SCHED_FENCE();
                {   const s16x16 ob0 = __builtin_bit_cast(s16x16, __builtin_convertvector(o0, bf16x16_t)), ob1 = __builtin_bit_cast(s16x16, __builtin_convertvector(o1, bf16x16_t));
#pragma unroll
                    for (int reg = 0; reg < 16; ++reg) { *(unsigned short*)(img + ((reg & 3) + 8 * (reg >> 2) + 4 * h) * 80 + 2 * r) = (unsigned short)ob0[reg];
                        *(unsigned short*)(img + (32 + (reg & 3) + 8 * (reg >> 2) + 4 * h) * 80 + 2 * r) = (unsigned short)ob1[reg]; } }
                pwr = wr; pR0 = R0;
            }
            {   s16x8 fkt[16];
#pragma unroll
                for (int i = 0; i < 16; ++i) fkt[i] = *(const s16x8*)(buf + DNB_KT + (i * 64 + lane) * 16);
                const float egl = sc[256];
#pragma unroll
                for (int st = 0; st < 4; ++st) S[st] = S[st] * egl;
                SCHED_FENCE();
#pragma unroll
                for (int s = 0; s < 4; ++s)
#pragma unroll
                    for (int st = 0; st < 4; ++st) S[st] = MFMA32(fkt[st * 4 + s], Vw[s], S[st]);
                SCHED_FENCE();
            }
#undef SCHED_FENCE
        }
        __syncthreads();
    }
    if (wid < 4 && pwr) { bf16_t* op = od + OADDR(pR0 + (lane >> 2), hd * 128 + 32 * (wid & 3) + 8 * (lane & 3));
#pragma unroll
        for (int q = 0; q < 4; ++q) *(u32x4*)(op + (size_t)q * 8 * 2048) = *(const u32x4*)(img + (16 * q + (lane >> 2)) * 80 + 16 * (lane & 3)); }
}

constexpr int SSB_BT = 16384, SSB_CB = 32768, SSB_SC = 40960, SSB_BYTES = 40960 + 2 * 1280, SS_IMG = 2 * SSB_BYTES, SS_SCR = SS_IMG + 4 * 5120;
struct SsdStage { Band bc, bb; u32x4 cp[2]; float dtv, Aneg; };
__device__ __forceinline__ void ssd_stage_load(SsdStage& q, const Params& p, int l, int b, int d, int g, int head0, int cidx, int hw, int lane) {
    asm volatile("" : "+s"(hw));
    const bf16_t* F = (const bf16_t*)(p.ws + WS_F); const float* SM = (const float*)(p.ws + WS_SM); const size_t R0 = chunk_row0(b, cidx);
    const bf16_t* FB = F + FADDR(R0, 2048 + g * 128); const bf16_t* FC = F + FADDR(R0, 2304 + g * 128);
    const unsigned char* cb = p.ws + WS_CB + ((size_t)(b * 68 + cidx) * 2 + g) * 8192;
    band_load(q.bc, FC, hw, lane); band_load(q.bb, FB, hw, lane);
    const int t256 = hw * 64 + lane;
#pragma unroll
    for (int i = 0; i < 2; ++i) q.cp[i] = *(const u32x4*)(cb + (size_t)(i * 256 + t256) * 16);
    const int tok = d ? 63 - lane : lane;
    const int head = head0 + (hw & 1);
    q.Aneg = -__expf(p.ssm_A_log[(l * 2 + d) * 8 + head]); q.dtv = SM[(R0 + tok) * 32 + 16 + d * 8 + head] + p.ssm_dt_bias[(l * 2 + d) * 8 + head];
}
__device__ __forceinline__ void ssd_stage_store(const SsdStage& q, int d, unsigned char* buf, unsigned char* scr, int hw, int lane) {
    asm volatile("" : "+s"(hw));
    const int t256 = hw * 64 + lane;
    band_store_perm(q.bc, buf, hw, lane); band_store_perm(q.bb, scr, hw, lane); band_store_transposed(scr, buf + SSB_BT, hw, lane);
#pragma unroll
    for (int i = 0; i < 2; ++i) *(u32x4*)(buf + SSB_CB + (i * 256 + t256) * 16) = q.cp[i];
    if (hw < 2) {
        const int tok = d ? 63 - lane : lane; const float dtv = softplus_f(q.dtv);
        float x = dtv * q.Aneg;
        x = wave_incl_scan(x, lane);
        const float al = lane_get(x, 63);
        float* sc = (float*)(buf + SSB_SC) + hw * 320;
        sc[tok] = x * 1.4426950408889634f; sc[64 + tok] = dtv; sc[128 + tok] = dtv * __expf(al - x); sc[192 + tok] = __expf(x); if (lane == 0) sc[256] = __expf(al);
    }
}
template <int DIR> __device__ __forceinline__ void ssd_scan_block(const Params& p, int l, int idx, unsigned char* smem, bool ctx_out, int wid) {
    constexpr int d = DIR; const int b = idx >> 3, g = (idx >> 1) & 1, head0 = g * 4 + (idx & 1) * 2;
    int lane = __builtin_amdgcn_mbcnt_hi(~0u, __builtin_amdgcn_mbcnt_lo(~0u, 0u)); asm volatile("" : "+v"(lane)); int r = lane & 31, h = lane >> 5;
    const bf16_t* F = (const bf16_t*)(p.ws + WS_F); bf16_t* od = (bf16_t*)(p.ws + WS_OD) + (size_t)d * NROW * 1024;
    if (wid >= 4) {
        SsdStage q;
        ssd_stage_load(q, p, l, b, d, g, head0, scan_chunk(d, 0), wid - 4, lane); ssd_stage_store(q, d, smem, smem + SS_SCR, wid - 4, lane);
        ssd_stage_load(q, p, l, b, d, g, head0, scan_chunk(d, 1), wid - 4, lane);
        __syncthreads();
        for (int step = 0; step < 68; ++step) {
            lane = __builtin_amdgcn_mbcnt_hi(~0u, __builtin_amdgcn_mbcnt_lo(~0u, 0u)); asm volatile("" : "+v"(lane));
            if (step + 1 < 68) ssd_stage_store(q, d, smem + ((step + 1) & 1) * SSB_BYTES, smem + SS_SCR, wid - 4, lane);
            if (step + 2 < 68) ssd_stage_load(q, p, l, b, d, g, head0, scan_chunk(d, step + 2), wid - 4, lane);
            __syncthreads();
        }
        return;
    }
    const int hsel = (wid >> 1) & 1, head = head0 + hsel; int pcol = head * 64 + 32 * (wid & 1) + r;
    __builtin_amdgcn_s_setprio(2);
    f32x16 H[4];
#pragma unroll
    for (int i = 0; i < 4; ++i) H[i] = zero16();
    u32x4 xrow[4];
    const int xcol0 = 1536 + head * 64 + 32 * (wid & 1);
    unsigned char* img = smem + SS_IMG + (wid & 3) * IMG_BYTES;
    if (wid < 4) rows_load(xrow, F + FADDR(chunk_row0(b, scan_chunk(d, 0)), xcol0), lane);
    bool pwr = false; size_t pR0 = 0;
    __syncthreads();
    for (int step = 0; step < 68; ++step) {
        lane = __builtin_amdgcn_mbcnt_hi(~0u, __builtin_amdgcn_mbcnt_lo(~0u, 0u)); asm volatile("" : "+v"(lane)); r = lane & 31; h = lane >> 5; pcol = head * 64 + 32 * (wid & 1) + r;
        unsigned char* buf = smem + (step & 1) * SSB_BYTES;
        {
            const int cidx = scan_chunk(d, step); const size_t R0 = chunk_row0(b, cidx);
            u32x4 orow[4];
#pragma unroll
            for (int q = 0; q < 4; ++q) orow[q] = *(const u32x4*)(img + (16 * q + (lane >> 2)) * 80 + 16 * (lane & 3));
            rows_park(xrow, img, lane);
            if (step > 0 && pwr) { bf16_t* op = od + OADDR(pR0 + (lane >> 2), 512 + head * 64 + 32 * (wid & 1) + 8 * (lane & 3));
#pragma unroll
                for (int q = 0; q < 4; ++q) *(u32x4*)(op + (size_t)q * 8 * 2048) = orow[q]; }
            if (step + 1 < 68) rows_load(xrow, F + FADDR(chunk_row0(b, scan_chunk(d, step + 1)), xcol0), lane);
            s16x8 xf[4];
            frags_from_img(xf, img, r, h);
            const float* sc = (const float*)(buf + SSB_SC) + hsel * 320;
            const bool wr = (cidx >= 4) || ctx_out;
            if (wr) {
                s16x8 xd[4];
#pragma unroll
                for (int s = 0; s < 4; ++s) { float v1[8];
#pragma unroll
                    for (int q4 = 0; q4 < 2; ++q4) { const f32x4 dt4 = *(const f32x4*)(sc + 64 + 16 * s + 8 * q4 + 4 * h);
#pragma unroll
                        for (int e = 0; e < 4; ++e) v1[4 * q4 + e] = bf2f((unsigned short)xf[s][4 * q4 + e]) * dt4[e]; }
                    xd[s] = cvt8(v1[0], v1[1], v1[2], v1[3], v1[4], v1[5], v1[6], v1[7]); }
                const int rr = r - 4 * h;
#pragma unroll
                for (int t = 0; t < 2; ++t) {
                    f32x16 y = zero16();
#pragma unroll
                    for (int s = 0; s < 8; ++s) y = MFMA32(*(const s16x8*)(buf + ((t * 8 + s) * 64 + lane) * 16), PACK_STEP(H[s >> 1], s & 1), y);
#pragma unroll
                    for (int q4 = 0; q4 < 4; ++q4) { const f32x4 ea = *(const f32x4*)(sc + 192 + 32 * t + 8 * q4 + 4 * h);
#pragma unroll
                        for (int e = 0; e < 4; ++e) y[4 * q4 + e] *= ea[e]; }
                    const float ai = sc[32 * t + r];
#pragma unroll
                    for (int s = 0; s < 4; ++s) {
                        const bool diag = (s >> 1) == t, full = d ? ((s >> 1) > t) : ((s >> 1) < t);
                        if (diag || full) {
                            const s16x8 raw = *(const s16x8*)(buf + SSB_CB + ((t * 4 + s) * 64 + lane) * 16); float v[8];
#pragma unroll
                            for (int q4 = 0; q4 < 2; ++q4) { const f32x4 aj = *(const f32x4*)(sc + 16 * s + 8 * q4 + 4 * h);
#pragma unroll
                                for (int e = 0; e < 4; ++e) { const int cj = 16 * (s & 1) + 8 * q4 + e; const float val = bf2f((unsigned short)raw[4 * q4 + e]) * __builtin_amdgcn_exp2f(ai - aj[e]);
                                    v[4 * q4 + e] = diag ? ((d ? (cj >= rr) : (cj <= rr)) ? val : 0.f) : val; } }
                            y = MFMA32(cvt8(v[0], v[1], v[2], v[3], v[4], v[5], v[6], v[7]), xd[s], y); } }
                    { const s16x16 yb = __builtin_bit_cast(s16x16, __builtin_convertvector(y, bf16x16_t));
#pragma unroll
                    for (int reg = 0; reg < 16; ++reg) *(unsigned short*)(img + (32 * t + (reg & 3) + 8 * (reg >> 2) + 4 * h) * 80 + 2 * r) = (unsigned short)yb[reg]; }
                    asm volatile("" ::: "memory"); }
                asm volatile("" ::: "memory"); }
            pwr = wr; pR0 = R0;
            s16x8 xw[4];
#pragma unroll
            for (int s = 0; s < 4; ++s) { float v2[8];
#pragma unroll
                for (int q4 = 0; q4 < 2; ++q4) { const int j0 = 16 * s + 8 * q4 + 4 * h; const f32x4 w4 = *(const f32x4*)(sc + 128 + j0);
#pragma unroll
                    for (int e = 0; e < 4; ++e) v2[4 * q4 + e] = bf2f((unsigned short)xf[s][4 * q4 + e]) * w4[e]; }
                xw[s] = cvt8(v2[0], v2[1], v2[2], v2[3], v2[4], v2[5], v2[6], v2[7]); }
            const float eal = sc[256];
#pragma unroll
            for (int nt = 0; nt < 4; ++nt) { f32x16 a = H[nt] * eal;
#pragma unroll
                for (int s = 0; s < 4; ++s) a = MFMA32(*(const s16x8*)(buf + SSB_BT + ((nt * 4 + s) * 64 + lane) * 16), xw[s], a);
                H[nt] = a; }
        }
        __syncthreads();
    }
    if (wid < 4 && pwr) { bf16_t* op = od + OADDR(pR0 + (lane >> 2), 512 + head * 64 + 32 * (wid & 1) + 8 * (lane & 3));
#pragma unroll
        for (int q = 0; q < 4; ++q) *(u32x4*)(op + (size_t)q * 8 * 2048) = *(const u32x4*)(img + (16 * q + (lane >> 2)) * 80 + 16 * (lane & 3)); }
}
__device__ __forceinline__ void phase_scan_mfma(const Params& p, int l, unsigned char* smem, bool ctx_out, const int tid, const int bid, const int nblk) {
    const int wid = __builtin_amdgcn_readfirstlane(tid >> 6);
    for (int it = bid; it < 256; it += nblk) {
        if (it < 128) { if (PROBE_DN) dn_scan_chain(p, it, smem, ctx_out, wid); }
        else { const int idx = it - 128; if ((idx >> 2) & 1) ssd_scan_block<1>(p, l, idx, smem, ctx_out, wid); else ssd_scan_block<0>(p, l, idx, smem, ctx_out, wid); }
        __builtin_amdgcn_s_setprio(0);
        __syncthreads();
    }
}

__device__ __forceinline__ void phase_merge(const Params& p, int l, int nrows, const int tid, const int bid, const int nblk) {
    const int lane = tid & 63, gw = bid * 8 + (tid >> 6), NGW = nblk * 8;
    const bf16_t* F = (const bf16_t*)(p.ws + WS_F); const bf16_t* PR = (const bf16_t*)(p.ws + WS_PR); const bf16_t* OD0 = (const bf16_t*)(p.ws + WS_OD); const bf16_t* OD1 = OD0 + (size_t)NROW * 1024;
    bf16_t* MIX = (bf16_t*)(p.ws + WS_MIX);
    const int cd = lane * 8;
    float gdn[8], gss[8];
#pragma unroll
    for (int i = 0; i < 8; ++i) { gdn[i] = p.dn_norm_g[l * 128 + (cd & 127) + i]; gss[i] = p.ssm_norm_g[l * 512 + cd + i]; }
    const float Dh = p.ssm_D[l * 8 + (lane >> 3)];
    for (int R0 = 2 * gw; R0 < nrows; R0 += 2 * NGW) {
        u32x4 la0[2], la1[2], lz0[2], ly0[2], ly1[2], lz1[2], lxf[2];
#pragma unroll
        for (int k = 0; k < 2; ++k) { const size_t ro = (size_t)(R0 + k) * 1024;
            la0[k] = *(const u32x4*)(OD0 + OADDR(R0 + k, cd)); la1[k] = *(const u32x4*)(OD1 + OADDR(R0 + k, cd)); lz0[k] = *(const u32x4*)(PR + ro + cd);
            ly0[k] = *(const u32x4*)(OD0 + OADDR(R0 + k, 512 + cd)); ly1[k] = *(const u32x4*)(OD1 + OADDR(R0 + k, 512 + cd)); lz1[k] = *(const u32x4*)(PR + ro + 512 + cd); lxf[k] = *(const u32x4*)(F + FADDR(R0 + k, 1536 + cd)); }
#pragma unroll
        for (int k = 0; k < 2; ++k) {
        const size_t ro = (size_t)(R0 + k) * 1024;
        const u32x4 a0 = la0[k], a1 = la1[k], z0 = lz0[k], y0 = ly0[k], y1 = ly1[k], z1 = lz1[k], xf = lxf[k];
        float o[8], yz[8];
        { const unsigned aa[4] = {a0.x, a0.y, a0.z, a0.w}, bb[4] = {a1.x, a1.y, a1.z, a1.w};
#pragma unroll
            for (int i = 0; i < 4; ++i) { o[2 * i] = lo_bf(aa[i]) + lo_bf(bb[i]); o[2 * i + 1] = hi_bf(aa[i]) + hi_bf(bb[i]); } }
        { const unsigned aa[4] = {y0.x, y0.y, y0.z, y0.w}, bb[4] = {y1.x, y1.y, y1.z, y1.w}, xx[4] = {xf.x, xf.y, xf.z, xf.w}, zz[4] = {z1.x, z1.y, z1.z, z1.w};
#pragma unroll
            for (int i = 0; i < 4; ++i) { yz[2 * i] = (lo_bf(aa[i]) + lo_bf(bb[i]) + Dh * lo_bf(xx[i])) * silu_f(lo_bf(zz[i])); yz[2 * i + 1] = (hi_bf(aa[i]) + hi_bf(bb[i]) + Dh * hi_bf(xx[i])) * silu_f(hi_bf(zz[i])); } }
        float s1 = 0.f, s2 = 0.f;
#pragma unroll
        for (int i = 0; i < 8; ++i) { s1 += o[i] * o[i]; s2 += yz[i] * yz[i]; }
        s1 += dppf<0xB1>(s1); s1 += dppf<0x4E>(s1); s1 += dppf<0x141>(s1); s1 += dppf<0x140>(s1);
        s2 += dppf<0xB1>(s2); s2 += dppf<0x4E>(s2); s2 += dppf<0x141>(s2); s2 += dppf<0x140>(s2); s2 += sxor<16>(s2);
        const float r1 = rsqrtf(s1 * (1.f / 128.f) + EPS), r2 = rsqrtf(s2 * (1.f / 256.f) + EPS);
        const unsigned zz[4] = {z0.x, z0.y, z0.z, z0.w};
        float dn[8], ss[8];
#pragma unroll
        for (int i = 0; i < 4; ++i) { dn[2 * i] = o[2 * i] * r1 * gdn[2 * i] * silu_f(lo_bf(zz[i])); dn[2 * i + 1] = o[2 * i + 1] * r1 * gdn[2 * i + 1] * silu_f(hi_bf(zz[i])); }
#pragma unroll
        for (int i = 0; i < 8; ++i) ss[i] = yz[i] * r2 * gss[i];
        u32x4 w0, w1; w0.x = pk2(dn[0], dn[1]); w0.y = pk2(dn[2], dn[3]); w0.z = pk2(dn[4], dn[5]); w0.w = pk2(dn[6], dn[7]);
        w1.x = pk2(ss[0], ss[1]); w1.y = pk2(ss[2], ss[3]); w1.z = pk2(ss[4], ss[5]); w1.w = pk2(ss[6], ss[7]);
        *(u32x4*)(MIX + ro + cd) = w0; *(u32x4*)(MIX + ro + 512 + cd) = w1;
        }
    }
}

__device__ __forceinline__ void phase_resid1(const Params& p, int l, unsigned char* smem, int nrows, const int tid, const int bid, const int nblk) {
    float* rw = (float*)smem;
    const int lane = tid & 63, gw = bid * 8 + (tid >> 6), NGW = nblk * 8;
    for (int i = tid; i < 16384; i += 512) rw[(i & 15) * 1024 + (i >> 4)] = p.router_w[(size_t)l * 16384 + i];
    __syncthreads();
    const bf16_t* M = (const bf16_t*)(p.ws + WS_M); const float* mod = (const float*)(p.ws + WS_MOD);
    float* aff = (float*)(p.ws + WS_AFF); float* affb = (float*)(smem + 65536 + (size_t)(tid >> 6) * 4096);
    const float* g1 = p.norm_g + (l * 4 + 1) * D; const float* g2 = p.norm_g + (l * 4 + 2) * D;
    const int rpw = (nrows / 2 + NGW - 1) / NGW * 2, rbeg = gw * rpw, rend = (rbeg + rpw < nrows) ? rbeg + rpw : nrows;
    f32x4 cg1[4], cg2[4], cgt[4], csh[4], csc[4]; int cur_r = -1;
#pragma unroll
    for (int j = 0; j < 4; ++j) { cg1[j] = *(const f32x4*)(g1 + 256 * j + 4 * lane); cg2[j] = *(const f32x4*)(g2 + 256 * j + 4 * lane); }
    for (int R0 = rbeg; R0 < rend; R0 += 2) {
        u32x2 lm[2][4]; f32x4 lx[2][4];
#pragma unroll
        for (int k = 0; k < 2; ++k) {
#pragma unroll
            for (int j = 0; j < 4; ++j) { const int i = 256 * j + 4 * lane; lm[k][j] = *(const u32x2*)(M + (size_t)(R0 + k) * D + i); }
            if (l == 0) { const float* xr = xres_in(p, 0, R0 + k);
#pragma unroll
                for (int j = 0; j < 4; ++j) lx[k][j] = *(const f32x4*)(xr + 256 * j + 4 * lane); }
            else { const bf16_t* xr = xb_ptr(p, R0 + k);
#pragma unroll
                for (int j = 0; j < 4; ++j) lx[k][j] = unpack4(*(const u32x2*)(xr + 256 * j + 4 * lane)); } }
#pragma unroll
        for (int k = 0; k < 2; ++k) {
        const int R = R0 + k; bf16_t* xo = (l == DEPTH - 1) ? xl_ptr(p, R) : xb_ptr(p, R);
        { const int mr = __builtin_amdgcn_readfirstlane(row_modr(R)); if (mr != cur_r) { cur_r = mr; const float* md = mod + (size_t)(l * 17 + mr) * NMOD;
#pragma unroll
                for (int j = 0; j < 4; ++j) { const int i = 256 * j + 4 * lane; cgt[j] = *(const f32x4*)(md + 2 * D + i); csh[j] = *(const f32x4*)(md + 3 * D + i); csc[j] = *(const f32x4*)(md + 4 * D + i); } } }
        f32x4 mv[4], xv[4]; float ss = 0.f;
#pragma unroll
        for (int j = 0; j < 4; ++j) { const u32x2 t = lm[k][j];
            mv[j] = (f32x4){lo_bf(t.x), hi_bf(t.x), lo_bf(t.y), hi_bf(t.y)}; xv[j] = lx[k][j];
            ss += mv[j].x * mv[j].x + mv[j].y * mv[j].y + mv[j].z * mv[j].z + mv[j].w * mv[j].w; }
        const float rstd = rsqrtf(wave_sum(ss, lane) * (1.f / D) + EPS);
        float ss2 = 0.f;
#pragma unroll
        for (int j = 0; j < 4; ++j) { const int i = 256 * j + 4 * lane;
            xv[j] = xv[j] + cgt[j] * (mv[j] * rstd * cg1[j]); { u32x2 o; o.x = pk2(xv[j].x, xv[j].y); o.y = pk2(xv[j].z, xv[j].w); *(u32x2*)(xo + i) = o; xv[j] = unpack4(o); }
            ss2 += xv[j].x * xv[j].x + xv[j].y * xv[j].y + xv[j].z * xv[j].z + xv[j].w * xv[j].w; }
        const float rstd2 = rsqrtf(wave_sum(ss2, lane) * (1.f / D) + EPS);
        f32x4 hv[4];
#pragma unroll
        for (int j = 0; j < 4; ++j) hv[j] = xv[j] * rstd2 * cg2[j] * (csc[j] + 1.f) + csh[j];
        { bf16_t* h2row = (bf16_t*)(p.ws + WS_H2) + (size_t)R * D;
#pragma unroll
            for (int j = 0; j < 4; ++j) { u32x2 o; o.x = pk2(hv[j].x, hv[j].y); o.y = pk2(hv[j].z, hv[j].w); *(u32x2*)(h2row + 256 * j + 4 * lane) = o; } }
        float ps[16];
#pragma unroll
        for (int e = 0; e < 16; ++e) { float sacc = 0.f;
#pragma unroll
            for (int j = 0; j < 4; ++j) { const f32x4 wv = *(const f32x4*)(rw + e * 1024 + 256 * j + 4 * lane); sacc += hv[j].x * wv.x + hv[j].y * wv.y + hv[j].z * wv.z + hv[j].w * wv.w; }
            ps[e] = sacc; if ((e & 3) == 3) asm volatile("" ::: "memory"); }
        const bool b5 = (lane & 32) != 0, b4 = (lane & 16) != 0, b3 = (lane & 8) != 0, b2 = (lane & 4) != 0;
        float v8[8], v4[4], v2[2], lg1;
#pragma unroll
        for (int i = 0; i < 8; ++i) { const float snd = b5 ? ps[i] : ps[8 + i]; const float kp = b5 ? ps[8 + i] : ps[i]; v8[i] = kp + lane_get(snd, lane ^ 32); }
#pragma unroll
        for (int i = 0; i < 4; ++i) { const float snd = b4 ? v8[i] : v8[4 + i]; const float kp = b4 ? v8[4 + i] : v8[i]; v4[i] = kp + sxor<16>(snd); }
#pragma unroll
        for (int i = 0; i < 2; ++i) { const float snd = b3 ? v4[i] : v4[2 + i]; const float kp = b3 ? v4[2 + i] : v4[i]; v2[i] = kp + sxor<8>(snd); }
        { const float snd = b2 ? v2[0] : v2[1]; const float kp = b2 ? v2[1] : v2[0]; lg1 = kp + sxor<4>(snd); }
        lg1 += sxor<2>(lg1); lg1 += sxor<1>(lg1);
        float mx = lg1;
        mx = fmaxf(mx, sxor<4>(mx)); mx = fmaxf(mx, sxor<8>(mx)); mx = fmaxf(mx, sxor<16>(mx)); mx = fmaxf(mx, lane_get(mx, lane ^ 32));
        const float ex = __expf(lg1 - mx);
        float den = ex;
        den += sxor<4>(den); den += sxor<8>(den); den += sxor<16>(den); den += lane_get(den, lane ^ 32);
        if ((lane & 3) == 0) { const int e = ((lane >> 5) & 1) * 8 + ((lane >> 4) & 1) * 4 + ((lane >> 3) & 1) * 2 + ((lane >> 2) & 1);
            affb[e * 64 + (R - rbeg)] = ex * __builtin_amdgcn_rcpf(den); }
        }
    }
    asm volatile("s_waitcnt lgkmcnt(0)" ::: "memory");
    { const int nrw = rend > rbeg ? rend - rbeg : 0, nel = nrw * 16;
        for (int i2 = lane; i2 < nel; i2 += 64) { const int e = i2 / nrw, rl = i2 - e * nrw, R = rbeg + rl;
            const size_t ai = R < NLAT ? ((size_t)((R >> 12) * 16 + e) * SEQ + (R & (SEQ - 1))) : ((size_t)NLAT * 16 + (size_t)(((R - NLAT) >> 8) * 16 + e) * CTXL + ((R - NLAT) & (CTXL - 1)));
            aff[ai] = affb[e * 64 + rl]; } }
}

template <int NPL> __device__ __forceinline__ void topk_wave(const float* affset, int rowbase, int k, int outbase, int* selt, float* selg, int* slotT, unsigned* kl, int* sout, int lane) {
    unsigned prefix = 0u;
    {   unsigned key[NPL];
#pragma unroll
        for (int i = 0; i < NPL; ++i) { key[i] = __float_as_uint(affset[lane * NPL + i]); kl[i * 64 + lane] = key[i]; }
        for (int bit = 30; bit >= 0; --bit) {
            const unsigned cand = prefix | (1u << bit); int c = 0;
#pragma unroll
            for (int i = 0; i < NPL; ++i) c += (key[i] >= cand) ? 1 : 0;
            if (wave_sum_i(c, lane) >= k) prefix = cand;
        }
    }
    int cgt = 0, ceq = 0;
#pragma unroll 4
    for (int i = 0; i < NPL; ++i) { const unsigned ky = kl[i * 64 + lane]; cgt += (ky > prefix) ? 1 : 0; ceq += (ky == prefix) ? 1 : 0; }
    const int need_eq = k - wave_sum_i(cgt, lane);
    const int eq0 = wave_incl_scan_i(ceq, lane) - ceq;
    int eq_rank = eq0, csel = 0;
#pragma unroll 4
    for (int i = 0; i < NPL; ++i) { const unsigned ky = kl[i * 64 + lane]; const bool iseq = ky == prefix; const bool sl = (ky > prefix) || (iseq && eq_rank < need_eq); if (iseq) ++eq_rank; csel += sl ? 1 : 0; }
    int pos = wave_incl_scan_i(csel, lane) - csel;
    eq_rank = eq0;
#pragma unroll 4
    for (int i = 0; i < NPL; ++i) { const unsigned ky = kl[i * 64 + lane]; const int R = rowbase + lane * NPL + i; const bool iseq = ky == prefix; const bool sl = (ky > prefix) || (iseq && eq_rank < need_eq); if (iseq) ++eq_rank;
        int v = -1;
        if (sl) { const int row = outbase + pos; ++pos; selt[row] = R; selg[row] = __uint_as_float(ky); v = row; }
        if (sout) sout[lane * (NPL + 1) + i] = v; else slotT[lane * NPL + i] = v; }
    if (sout) { asm volatile("" ::: "memory");
#pragma unroll 4
        for (int j = 0; j < NPL; ++j) { const int t = j * 64 + lane; slotT[t] = sout[(t / NPL) * (NPL + 1) + (t % NPL)]; } }
}
__device__ __forceinline__ void phase_topk(const Params& p, unsigned char* smem, bool with_ctx, const int tid, const int bid, const int nblk) {
    const int lane = tid & 63, wid = __builtin_amdgcn_readfirstlane(tid >> 6), gw = bid * 8 + wid, NGW = nblk * 8;
    const float* aff = (const float*)(p.ws + WS_AFF); int* selt = (int*)(p.ws + WS_SELT); float* selg = (float*)(p.ws + WS_SELG); int* slot = (int*)(p.ws + WS_SLOT);
    unsigned* kl = (unsigned*)(smem + (size_t)wid * 16384);
    const int nitems = with_ctx ? 512 : 256;
    for (int it = (nblk == 256 ? wid * 256 + bid : gw); it < nitems; it += (nblk == 256 ? 2048 : NGW)) {
        const int b = (it & 255) >> 4, e = it & 15;
        int* sout = (nblk == 256) ? (int*)(smem + 102400 + (size_t)wid * 16640) : (int*)nullptr;
        if (it < 256) topk_wave<64>(aff + (size_t)(b * 16 + e) * SEQ, b * SEQ, 512, (b * 16 + e) * 512, selt, selg, slot + (size_t)(b * 16 + e) * SEQ, kl, sout, lane);
        else topk_wave<4>(aff + (size_t)NLAT * 16 + (size_t)(b * 16 + e) * CTXL, NLAT + b * CTXL, 32, (256 + e) * 512 + b * 32, selt, selg, slot + (size_t)NLAT * 16 + (size_t)(b * 16 + e) * CTXL, kl, sout, lane);
    }
}

__device__ __forceinline__ void phase_resid2(const Params& p, int l, int nrows, unsigned char* smem, const int tid, const int bid, const int nblk) {
    const int lane = tid & 63, wid = __builtin_amdgcn_readfirstlane(tid >> 6), gw = bid * 8 + wid, NGW = nblk * 8;
    const int* slot = (const int*)(p.ws + WS_SLOT); const bf16_t* YE = (const bf16_t*)(p.ws + WS_YE); const float* mod = (const float*)(p.ws + WS_MOD);
    const bf16_t* ZR = (const bf16_t*)(p.ws + WS_ZROW);
    bf16_t* H = (bf16_t*)(p.ws + WS_H); const float* g3 = p.norm_g + (l * 4 + 3) * D;
    const int rpw = (nrows / 2 + NGW - 1) / NGW * 2, rbeg = gw * rpw, rend = (rbeg + rpw < nrows) ? rbeg + rpw : nrows;
    f32x4 cg3[4], cg0[4], cgt[4], csh[4], csc[4]; int cur_r = -1;
#pragma unroll
    for (int j = 0; j < 4; ++j) { cg3[j] = *(const f32x4*)(g3 + 256 * j + 4 * lane); cg0[j] = *(const f32x4*)(p.norm_g + (((l + 1 < DEPTH) ? l + 1 : l) * 4 + 0) * D + 256 * j + 4 * lane); }
    int* sls = (int*)(smem + (size_t)wid * 4096);
    { const int nrw = rend > rbeg ? rend - rbeg : 0, nint = nrw * 16;
        for (int i = lane; i < nint; i += 64) { const int e = i / nrw, rl = i - e * nrw, R = rbeg + rl;
            const size_t a = R < NLAT ? ((size_t)((R >> 12) * 16 + e) * SEQ + (R & (SEQ - 1))) : ((size_t)NLAT * 16 + (size_t)(((R - NLAT) >> 8) * 16 + e) * CTXL + ((R - NLAT) & (CTXL - 1)));
            sls[rl * 16 + e] = slot[a]; } }
    asm volatile("s_waitcnt vmcnt(0) lgkmcnt(0)" ::: "memory");
    for (int R0 = rbeg; R0 < rend; R0 += 2) {
        int sl[2][16];
#pragma unroll
        for (int k = 0; k < 2; ++k) { const int4* sp = (const int4*)(sls + (size_t)(R0 + k - rbeg) * 16);
#pragma unroll
            for (int q = 0; q < 4; ++q) { const int4 t = sp[q]; sl[k][4 * q] = __builtin_amdgcn_readfirstlane(t.x); sl[k][4 * q + 1] = __builtin_amdgcn_readfirstlane(t.y); sl[k][4 * q + 2] = __builtin_amdgcn_readfirstlane(t.z); sl[k][4 * q + 3] = __builtin_amdgcn_readfirstlane(t.w); } }
        int cnt[2]; const bf16_t* rp[2][4];
#pragma unroll
        for (int k = 0; k < 2; ++k) { int c = 0, r0 = -1, r1 = -1, r2 = -1, r3 = -1;
#pragma unroll
            for (int e = 0; e < 16; ++e) { const int v = sl[k][e]; const bool ok = v >= 0;
                r0 = (ok && c == 0) ? v : r0; r1 = (ok && c == 1) ? v : r1; r2 = (ok && c == 2) ? v : r2; r3 = (ok && c == 3) ? v : r3; c += ok ? 1 : 0; }
            cnt[k] = c; rp[k][0] = r0 >= 0 ? YE + (size_t)r0 * D : ZR; rp[k][1] = r1 >= 0 ? YE + (size_t)r1 * D : ZR; rp[k][2] = r2 >= 0 ? YE + (size_t)r2 * D : ZR; rp[k][3] = r3 >= 0 ? YE + (size_t)r3 * D : ZR; }
        u32x2 ly[2][4][4]; f32x4 lx[2][4];
#pragma unroll
        for (int k = 0; k < 2; ++k) { const bf16_t* xo = (l == DEPTH - 1) ? xl_ptr(p, R0 + k) : xb_ptr(p, R0 + k);
#pragma unroll
            for (int q = 0; q < 4; ++q)
#pragma unroll
                for (int j = 0; j < 4; ++j) ly[k][q][j] = *(const u32x2*)(rp[k][q] + 256 * j + 4 * lane);
#pragma unroll
            for (int j = 0; j < 4; ++j) lx[k][j] = unpack4(*(const u32x2*)(xo + 256 * j + 4 * lane)); }
#pragma unroll
        for (int k = 0; k < 2; ++k) {
            const int R = R0 + k;
            { const int mr = __builtin_amdgcn_readfirstlane(row_modr(R)); if (mr != cur_r) { cur_r = mr; const float* md = mod + (size_t)(l * 17 + mr) * NMOD; const float* md2 = mod + (size_t)(((l + 1 < DEPTH) ? l + 1 : l) * 17 + mr) * NMOD;
#pragma unroll
                    for (int j = 0; j < 4; ++j) { const int i = 256 * j + 4 * lane; cgt[j] = *(const f32x4*)(md + 5 * D + i); csh[j] = *(const f32x4*)(md2 + i); csc[j] = *(const f32x4*)(md2 + D + i); } } }
            f32x4 yv[4];
#pragma unroll
            for (int j = 0; j < 4; ++j) { yv[j] = (f32x4){0.f, 0.f, 0.f, 0.f};
#pragma unroll
                for (int q = 0; q < 4; ++q) { const u32x2 t = ly[k][q][j]; yv[j] = yv[j] + (f32x4){lo_bf(t.x), hi_bf(t.x), lo_bf(t.y), hi_bf(t.y)}; } }
            if (cnt[k] > 4) { int c = 0;
                for (int e = 0; e < 16; ++e) { const int v = sl[k][e]; if (v >= 0) { if (c >= 4) {
#pragma unroll
                            for (int j = 0; j < 4; ++j) { const u32x2 t = *(const u32x2*)(YE + (size_t)v * D + 256 * j + 4 * lane); yv[j] = yv[j] + (f32x4){lo_bf(t.x), hi_bf(t.x), lo_bf(t.y), hi_bf(t.y)}; } }
                        ++c; } } }
            float ss = 0.f;
#pragma unroll
            for (int j = 0; j < 4; ++j) ss += yv[j].x * yv[j].x + yv[j].y * yv[j].y + yv[j].z * yv[j].z + yv[j].w * yv[j].w;
            const float rstd = rsqrtf(wave_sum(ss, lane) * (1.f / D) + EPS);
            f32x4 xv[4]; float ss2 = 0.f;
#pragma unroll
            for (int j = 0; j < 4; ++j) { const int i = 256 * j + 4 * lane;
                xv[j] = lx[k][j] + cgt[j] * (yv[j] * rstd * cg3[j]);
                if (l == DEPTH - 1) *(f32x4*)(p.out + (size_t)R * D + i) = xv[j];
                else { u32x2 o; o.x = pk2(xv[j].x, xv[j].y); o.y = pk2(xv[j].z, xv[j].w); *(u32x2*)(xb_ptr(p, R) + i) = o; xv[j] = unpack4(o); }
                ss2 += xv[j].x * xv[j].x + xv[j].y * xv[j].y + xv[j].z * xv[j].z + xv[j].w * xv[j].w; }
            if (l + 1 < DEPTH) { const float rstd2 = rsqrtf(wave_sum(ss2, lane) * (1.f / D) + EPS); bf16_t* hrow = H + (size_t)R * D;
#pragma unroll
                for (int j = 0; j < 4; ++j) { const f32x4 hq = xv[j] * rstd2 * cg0[j] * (csc[j] + 1.f) + csh[j]; u32x2 o; o.x = pk2(hq.x, hq.y); o.y = pk2(hq.z, hq.w); *(u32x2*)(hrow + 256 * j + 4 * lane) = o; } }
        }
    }
}

enum { PH_MODS = 0, PH_H0, PH_INPROJ, PH_CONV, PH_PREP, PH_SCAN, PH_MERGE, PH_OUTPROJ, PH_RESID1, PH_TOPK, PH_GATHER, PH_MOE1, PH_MOE2, PH_RESID2, PH_COUNT };

template <int PH> __device__ __forceinline__ void run_phase(const Params& p_in, int l, unsigned char* smem, int wid) {
    Params p = p_in; { __attribute__((address_space(1))) unsigned char* wsg = (__attribute__((address_space(1))) unsigned char*)p_in.ws; asm volatile("" : "+s"(wsg)); p.ws = (unsigned char*)wsg; }
    asm volatile("" : "+s"(wid));
    int tid = (int)__builtin_amdgcn_mbcnt_hi(~0u, __builtin_amdgcn_mbcnt_lo(~0u, 0u)), bid = blockIdx.x, nblk = gridDim.x;
    asm volatile("" : "+v"(tid)); tid += wid * 64; asm volatile("" : "+s"(bid)); asm volatile("" : "+s"(nblk));
    const bool last = (l == DEPTH - 1);
    const int nrows = last ? NLAT : NROW;
    const int nrouted = last ? 256 * 512 : 272 * 512;
    PG8_LAS unsigned char* lds = (PG8_LAS unsigned char*)smem;
    if constexpr (PH == PH_MODS) { if (bid == 0) ((unsigned*)(p.ws + WS_ZROW))[tid] = 0u;
        phase_mods(p, smem, tid, bid, nblk); __syncthreads(); phase_wconv(p, 0, smem, tid, bid, nblk, 0, 0); }
    if constexpr (PH == PH_H0) { phase_h0(p, tid, bid, nblk); }
    if constexpr (PH == PH_INPROJ) {
        pg8::Gemm g{(const bf16_t*)(p.ws + WS_H), (const bf16_t*)(p.ws + WS_WIN), NROW, NPROJ_PAD, D}; pg8::StaticOrder S; S.init(NROW, NPROJ_PAD, nblk, bid);
        EpiInProj E{(bf16_t*)(p.ws + WS_PC), (bf16_t*)(p.ws + WS_PR), (float*)(p.ws + WS_SM)};
        pg8::gemm_phase<EpiInProj, pg8::StaticOrder>(lds, g, S, E, tid);
    }
    if constexpr (PH == PH_CONV) { phase_conv(p, l, tid, bid, nblk); }
#if SCAN_NAIVE
    if constexpr (PH == PH_SCAN) { phase_scan_naive(p, l, smem, !last, tid, bid); }
#else
    if constexpr (PH == PH_PREP) { phase_prep(p, l, smem, tid, bid, nblk); }
    if constexpr (PH == PH_SCAN) { phase_scan_mfma(p, l, smem, !last, tid, bid, nblk); }
#endif
    if constexpr (PH == PH_MERGE) { phase_merge(p, l, nrows, tid, bid, nblk); }
    if constexpr (PH == PH_OUTPROJ) {
        pg8::Gemm g{(const bf16_t*)(p.ws + WS_MIX), (const bf16_t*)(p.ws + WS_WOUT), nrows, D, D}; pg8::StaticOrder S; S.init(nrows, D, nblk, bid);
        EpiPlain E{(bf16_t*)(p.ws + WS_M)};
        pg8::gemm_phase<EpiPlain, pg8::StaticOrder>(lds, g, S, E, tid);
        if (nblk == 256) phase_wconv(p, l, smem, tid, bid, nblk, 2, 512);
    }
    if constexpr (PH == PH_RESID1) { phase_resid1(p, l, smem, nrows, tid, bid, nblk); }
    if constexpr (PH == PH_TOPK) { phase_topk(p, smem, !last, tid, bid, nblk);
        if (nblk == 256) phase_wconv(p, l, smem, tid, bid, nblk, 3, -2); else { __syncthreads(); phase_wconv(p, l, smem, tid, bid, nblk, 1, 0); } }
    if constexpr (PH == PH_MOE1) {
        pg8::Gemm g{(const bf16_t*)(p.ws + WS_H2), (const bf16_t*)(p.ws + WS_WGU), nrouted, 1024, D}; pg8::MoeOrder S{nrouted / 256, nblk, bid};
        EpiSwiGLU E{(bf16_t*)(p.ws + WS_HID)};
        pg8::gemm_phase_gather<EpiSwiGLU, pg8::MoeOrder>(lds, g, S, E, tid, (const int*)(p.ws + WS_SELT));
    }
    if constexpr (PH == PH_MOE2) {
        pg8::Gemm g{(const bf16_t*)(p.ws + WS_HID), (const bf16_t*)(p.ws + WS_WD), nrouted, 1024, 512}; pg8::MoeOrder S{nrouted / 256, nblk, bid};
        EpiDown E{(bf16_t*)(p.ws + WS_YE), (const float*)(p.ws + WS_SELG)};
        pg8::gemm_phase<EpiDown, pg8::MoeOrder>(lds, g, S, E, tid);
    }
    if constexpr (PH == PH_RESID2) { phase_resid2(p, l, nrows, smem, tid, bid, nblk); if (!last) { __syncthreads(); phase_wconv(p, l + 1, smem, tid, bid, nblk, 0, 0); } }
}

#if MK_MULTI
template <int PH> __global__ void __launch_bounds__(512, 2) k_phase(Params p, int l) {
    extern __shared__ __attribute__((aligned(16))) unsigned char smem[];
    run_phase<PH>(p, l, smem, __builtin_amdgcn_readfirstlane((int)threadIdx.x >> 6));
}
#else
__global__ void __launch_bounds__(512, 2) mega(Params p) {
    extern __shared__ __attribute__((aligned(16))) unsigned char smem[];
    const int wid = __builtin_amdgcn_readfirstlane((int)threadIdx.x >> 6);
    uint4* xbw = (uint4*)(smem + LDS_XB_OFF);
    if (threadIdx.x == 0) *xbw = make_uint4(0u, 0u, 0u, 0u);
    __syncthreads();
    const unsigned xcc = xcd_barrier_post((unsigned*)(p.ws + WS_CTL), (volatile LAS unsigned*)xbw, threadIdx.x == 0).x;
#define GRID_BAR() do { unsigned x_ = xcc; int ln_ = (int)__builtin_amdgcn_mbcnt_hi(~0u, __builtin_amdgcn_mbcnt_lo(~0u, 0u)); unsigned char* w_ = p.ws; asm volatile("" : "+s"(x_)); asm volatile("" : "+v"(ln_)); asm volatile("" : "+s"(w_)); \
        XcdBarrier b_; b_.bar = (unsigned*)(w_ + WS_CTL); b_.x = x_; b_.st = (volatile LAS unsigned*)(smem + LDS_XB_OFF); \
        xcd_barrier(b_, wid == 0 && ln_ == 0); } while (0)
    run_phase<PH_MODS>(p, 0, smem, wid); GRID_BAR();
    run_phase<PH_H0>(p, 0, smem, wid); GRID_BAR();
    for (int l = 0; l < DEPTH; ++l) {
        run_phase<PH_INPROJ>(p, l, smem, wid); GRID_BAR();
        if (PROBE_DUP_MASK & (1 << PH_INPROJ)) { run_phase<PH_INPROJ>(p, l, smem, wid); GRID_BAR(); }
        run_phase<PH_CONV>(p, l, smem, wid); GRID_BAR();
        if (PROBE_DUP_MASK & (1 << PH_CONV)) { run_phase<PH_CONV>(p, l, smem, wid); GRID_BAR(); }
#if !SCAN_NAIVE
        run_phase<PH_PREP>(p, l, smem, wid); GRID_BAR();
        if (PROBE_DUP_MASK & (1 << PH_PREP)) { run_phase<PH_PREP>(p, l, smem, wid); GRID_BAR(); }
#endif
        run_phase<PH_SCAN>(p, l, smem, wid); GRID_BAR();
        if (PROBE_DUP_MASK & (1 << PH_SCAN)) { run_phase<PH_SCAN>(p, l, smem, wid); GRID_BAR(); }
        run_phase<PH_MERGE>(p, l, smem, wid); GRID_BAR();
        if (PROBE_DUP_MASK & (1 << PH_MERGE)) { run_phase<PH_MERGE>(p, l, smem, wid); GRID_BAR(); }
        run_phase<PH_OUTPROJ>(p, l, smem, wid); GRID_BAR();
        if (PROBE_DUP_MASK & (1 << PH_OUTPROJ)) { run_phase<PH_OUTPROJ>(p, l, smem, wid); GRID_BAR(); }
        run_phase<PH_RESID1>(p, l, smem, wid); GRID_BAR();
        run_phase<PH_TOPK>(p, l, smem, wid); GRID_BAR();
        if (PROBE_DUP_MASK & (1 << PH_TOPK)) { run_phase<PH_TOPK>(p, l, smem, wid); GRID_BAR(); }
        run_phase<PH_MOE1>(p, l, smem, wid); GRID_BAR();
        if (PROBE_DUP_MASK & (1 << PH_MOE1)) { run_phase<PH_MOE1>(p, l, smem, wid); GRID_BAR(); }
        run_phase<PH_MOE2>(p, l, smem, wid); GRID_BAR();
        if (PROBE_DUP_MASK & (1 << PH_MOE2)) { run_phase<PH_MOE2>(p, l, smem, wid); GRID_BAR(); }
        run_phase<PH_RESID2>(p, l, smem, wid); if (l + 1 < DEPTH) GRID_BAR();
    }
}
#endif

extern "C" void kernel_launch(void* const* d_in, const int* in_sizes, int n_in, void* d_out, int out_size, void* d_ws, size_t ws_size, hipStream_t stream) {
    static int grid = 0;
    if (grid == 0) {
        if (n_in != 22 || out_size != NLAT * D || ws_size < WS_END) { fprintf(stderr, "kernel_launch: unexpected shapes (n_in %d out %d ws %zu)\n", n_in, out_size, ws_size); grid = -1; return; }
        int dev = 0, cus = 0;
        if (hipGetDevice(&dev) != hipSuccess || hipDeviceGetAttribute(&cus, hipDeviceAttributeMultiprocessorCount, dev) != hipSuccess) { grid = -1; return; }
#if MK_MULTI
#define SETATTR(PH) (void)hipFuncSetAttribute((const void*)k_phase<PH>, hipFuncAttributeMaxDynamicSharedMemorySize, LDS_BYTES)
        SETATTR(0); SETATTR(1); SETATTR(2); SETATTR(3); SETATTR(4); SETATTR(5); SETATTR(6); SETATTR(7); SETATTR(8); SETATTR(9); SETATTR(10); SETATTR(11); SETATTR(12); SETATTR(13);
#else
        if (hipFuncSetAttribute((const void*)mega, hipFuncAttributeMaxDynamicSharedMemorySize, LDS_BYTES) != hipSuccess) { fprintf(stderr, "kernel_launch: hipFuncSetAttribute failed\n"); grid = -1; return; }
#endif
        (void)hipGetLastError();
        grid = cus;
    }
    if (grid < 0) return;
    Params p{};
    const float** pin = (const float**)&p;
    for (int i = 0; i < 22; ++i) pin[i] = (const float*)d_in[i];
    p.out = (float*)d_out; p.ws = (unsigned char*)d_ws;
#if MK_MULTI
#define LAUNCH(PH, l) hipLaunchKernelGGL(k_phase<PH>, dim3(grid), dim3(512), LDS_BYTES, stream, p, l)
    LAUNCH(PH_MODS, 0); LAUNCH(PH_H0, 0);
    for (int l = 0; l < DEPTH; ++l) { LAUNCH(PH_INPROJ, l); LAUNCH(PH_CONV, l); LAUNCH(PH_PREP, l); LAUNCH(PH_SCAN, l); LAUNCH(PH_MERGE, l); LAUNCH(PH_OUTPROJ, l); LAUNCH(PH_RESID1, l);
        LAUNCH(PH_TOPK, l); LAUNCH(PH_GATHER, l); LAUNCH(PH_MOE1, l); LAUNCH(PH_MOE2, l); LAUNCH(PH_RESID2, l); }
#else
    (void)hipMemsetAsync((char*)d_ws + WS_CTL, 0, XCD_BAR_WORDS * sizeof(unsigned), stream);
    hipLaunchKernelGGL(mega, dim3(grid), dim3(512), LDS_BYTES, stream, p);
#endif
}
```

```cpp
#include <hip/hip_runtime.h>
#include <cstdio>
#include <cstdint>

#ifndef SCAN_NAIVE
#define SCAN_NAIVE 0
#endif
#ifndef PROBE_SUBST_LO
#define PROBE_SUBST_LO 0
#endif
#ifndef PROBE_QK
#define PROBE_QK 1
#endif
#ifndef PROBE_SSD
#define PROBE_SSD 1
#endif
#ifndef PROBE_DN
#define PROBE_DN 1
#endif
#ifndef PROBE_SS
#define PROBE_SS 1
#endif
#ifndef PROBE_DUP_MASK
#define PROBE_DUP_MASK 0
#endif
#ifndef PREP_OLD
#define PREP_OLD 0
#endif
#ifndef MK_MULTI
#define MK_MULTI 0
#endif

namespace pg8 {
#define PG8_LAS __attribute__((address_space(3)))
typedef unsigned short bf16_t;
typedef short bf16x8 __attribute__((ext_vector_type(8)));
typedef float f32x4 __attribute__((ext_vector_type(4)));
typedef unsigned u32x4 __attribute__((ext_vector_type(4)));
constexpr int BM = 256, BK = 64, HALF = 128, HTB = HALF * BK * 2, STAGE_BYTES = 8 * HTB, NXCD = 8, WGM = 8;

__host__ __device__ __forceinline__ int lds_byte(int r, int c) { const int st = (r >> 4) * 2 + (c >> 5), rr = r & 15, cc = c & 31, ob = rr * 64 + cc * 2; return st * 1024 + (ob ^ (((ob >> 9) & 1) << 5)); }
__host__ __device__ __forceinline__ void stage_rc(int b, int& R, int& C) { const int st = b / 1024, sb = b % 1024, swz = sb ^ (((sb >> 9) & 1) << 5); R = (st >> 1) * 16 + swz / 64; C = (st & 1) * 32 + (swz % 64) / 2; }
__host__ __device__ __forceinline__ int perm32(int rho) { const int n = rho >> 4, i = rho & 15; return 8 * (i >> 2) + 4 * n + (i & 3); }

struct Unit { int pm, pn; };
struct Gemm { const bf16_t* A; const bf16_t* Bt; int M, N, K; };

struct StaticOrder {
    int nM, nN, nwg, G, c;
    __host__ __device__ void init(int M, int N, int G_, int c_) { nM = M / BM; nN = N / BM; nwg = nM * nN; G = G_; c = c_; }
    __host__ __device__ bool next(int i, Unit& u) const {
        const long L = (long)i * G + c; if (L >= nwg) return false;
        int wgid = (int)L; { const int q = nwg / NXCD, r = nwg % NXCD, xcd = wgid % NXCD, off = wgid / NXCD; wgid = (xcd < r ? xcd * (q + 1) : r * (q + 1) + (xcd - r) * q) + off; }
        const int nig = WGM * nN, gid = wgid / nig, fm = gid * WGM, gsz = (nM - fm) < WGM ? (nM - fm) : WGM;
        u.pm = fm + ((wgid % nig) % gsz); u.pn = (wgid % nig) / gsz; return true;
    }
    __device__ __forceinline__ void a_ready(const Unit&) const {}
    __device__ __forceinline__ void done(const Unit&) const {}
};
struct MoeOrder {
    int nM, G, c;
    __device__ bool next(int i, Unit& u) const {
        if (G & 31) { const long L = (long)i * G + c; if (L >= 4L * nM) return false; const int pm0 = (int)(L >> 2); u.pm = pm0; u.pn = (((pm0 >> 1) & 15) << 2) | (int)(L & 3); return true; }
        const int xcd = c & 7, q = c >> 3, j = q & 3, slot = q >> 2;
        const int pm = (G == 256) ? i * 64 + (slot >> 2) * 32 + 4 * xcd + (slot & 3) : i * (G >> 2) + slot * 8 + xcd; if (pm >= nM) return false;
        u.pm = pm; u.pn = (((pm >> 1) & 15) << 2) | j; return true;
    }
    __device__ __forceinline__ void a_ready(const Unit&) const {}
    __device__ __forceinline__ void done(const Unit&) const {}
};

__device__ __forceinline__ unsigned cvt_pk_bf16(float lo, float hi) { unsigned r; asm volatile("v_cvt_pk_bf16_f32 %0, %1, %2" : "=v"(r) : "v"(lo), "v"(hi)); return r; }

template <class Epi, class Sched>
__device__ __forceinline__ void gemm_phase(PG8_LAS unsigned char* lds, const Gemm g, const Sched& S, const Epi& E, const int tid) {
    const int wid = __builtin_amdgcn_readfirstlane(tid >> 6), lane = tid & 63, wr = wid >> 2, wc = wid & 3, fr = lane & 15, fq = lane >> 4;
    const int K = g.K, nt = K / BK;
    unsigned voffA[2], voffB[2];
#pragma unroll
    for (int i = 0; i < 2; ++i) { int R, C; stage_rc(tid * 16 + i * 8192, R, C);
        const int Rb = Epi::WIDE ? (64 * (R >> 5) + perm32(R & 31)) : (Epi::PERM ? ((R & ~31) + perm32(R & 31)) : R);
        voffA[i] = (unsigned)(R * K + C) * 2u; voffB[i] = (unsigned)(Rb * K + C) * 2u; }
    const size_t kstep = (size_t)(BK * 2);
    const size_t hstep = (size_t)HALF * K * 2;
    const size_t bhs = Epi::WIDE ? (size_t)32 * K * 2 : hstep;
    const size_t tstep = 2 * hstep;
    const unsigned ldsw = (unsigned)wid * 1024u;
    const int aoff = lds_byte(wr * 64 + fr, fq * 8), boff = lds_byte(wc * 32 + fr, fq * 8);
#define PG8_SA(b, h) (((b) * 2 + (h)) * HTB)
#define PG8_SB(b, h) ((4 + (b) * 2 + (h)) * HTB)
#define PG8_STAGE(bufoff, gbase, voff) do { _Pragma("unroll") for (int _i = 0; _i < 2; ++_i) \
        __builtin_amdgcn_global_load_lds((const unsigned*)((const char*)(gbase) + (voff)[_i]), (PG8_LAS unsigned*)(lds + (bufoff) + ldsw + _i * 8192), 16, 0, 0); } while (0)
#define PG8_LDA(dst, b, h) do { _Pragma("unroll") for (int m = 0; m < 4; ++m) _Pragma("unroll") for (int k = 0; k < 2; ++k) dst[m][k] = *(const PG8_LAS bf16x8*)(lds + PG8_SA(b, h) + aoff + m * 2048 + k * 1024); } while (0)
#define PG8_LDB(dst, b, h) do { _Pragma("unroll") for (int n = 0; n < 2; ++n) _Pragma("unroll") for (int k = 0; k < 2; ++k) dst[n][k] = *(const PG8_LAS bf16x8*)(lds + PG8_SB(b, h) + boff + n * 2048 + k * 1024); } while (0)
#define PG8_MMA(ai, bj, At, Bt) do { __builtin_amdgcn_s_setprio(1); _Pragma("unroll") for (int m = 0; m < 4; ++m) _Pragma("unroll") for (int n = 0; n < 2; ++n) _Pragma("unroll") for (int k = 0; k < 2; ++k) \
        acc[ai][bj][m][n] = __builtin_amdgcn_mfma_f32_16x16x32_bf16(Bt[n][k], At[m][k], acc[ai][bj][m][n], 0, 0, 0); __builtin_amdgcn_s_setprio(0); } while (0)
#define PG8_WAIT_V(n) asm volatile("s_waitcnt vmcnt(" #n ")" ::: "memory")
#define PG8_WAIT_L(n) asm volatile("s_waitcnt lgkmcnt(" #n ")" ::: "memory")
#define PG8_BAR __builtin_amdgcn_s_barrier()
#define PG8_SCHED __builtin_amdgcn_sched_barrier(0)
    Unit cur, nxt; int ui = 0;
    if (!S.next(0, cur)) return;
    f32x4 acc[2][2][4][2];
#pragma unroll
    for (int a = 0; a < 2; ++a)
#pragma unroll
        for (int b = 0; b < 2; ++b)
#pragma unroll
            for (int m = 0; m < 4; ++m)
#pragma unroll
                for (int n = 0; n < 2; ++n) acc[a][b][m][n] = (f32x4){0.f, 0.f, 0.f, 0.f};
    bf16x8 At[4][2], B0[2][2], B1[2][2];
    const char* cA = (const char*)g.A + (size_t)cur.pm * tstep; const char* cB = (const char*)g.Bt + (size_t)cur.pn * tstep;
    S.a_ready(cur);
    PG8_STAGE(PG8_SB(0, 0), cB, voffB); PG8_STAGE(PG8_SB(0, 1), cB + bhs, voffB); PG8_STAGE(PG8_SA(0, 0), cA, voffA); PG8_STAGE(PG8_SA(0, 1), cA + hstep, voffA);
    if (wr == 1) PG8_BAR;
    PG8_WAIT_V(2); PG8_BAR;
    PG8_STAGE(PG8_SB(1, 0), cB + kstep, voffB); PG8_STAGE(PG8_SA(1, 0), cA + kstep, voffA); PG8_STAGE(PG8_SB(1, 1), cB + bhs + kstep, voffB);
    PG8_WAIT_V(6); PG8_BAR;
    for (;;) {
        const bool has_next = S.next(ui + 1, nxt);
        const char* nA = has_next ? (const char*)g.A + (size_t)nxt.pm * tstep : cA; const char* nB = has_next ? (const char*)g.Bt + (size_t)nxt.pn * tstep : cB;
        for (int t = 0; t < nt; t += 2) {
            const bool last = (t == nt - 2);
            const char* a1 = cA + (size_t)(t + 1) * kstep;
            const char* a2 = last ? nA : cA + (size_t)(t + 2) * kstep; const char* b2 = last ? nB : cB + (size_t)(t + 2) * kstep;
            const char* a3 = a2 + kstep; const char* b3 = b2 + kstep;
            if (last && has_next) S.a_ready(nxt);
            PG8_LDB(B0, 0, 0); PG8_LDB(B1, 0, 1); PG8_SCHED; PG8_LDA(At, 0, 0); PG8_STAGE(PG8_SA(1, 1), a1 + hstep, voffA);
            PG8_WAIT_V(8); PG8_WAIT_L(0); PG8_BAR; PG8_MMA(0, 0, At, B0); PG8_MMA(0, 1, At, B1); PG8_BAR; PG8_SCHED;
            PG8_LDA(At, 0, 1); PG8_STAGE(PG8_SB(0, 0), b2, voffB); PG8_STAGE(PG8_SB(0, 1), b2 + bhs, voffB); PG8_STAGE(PG8_SA(0, 0), a2, voffA);
            PG8_WAIT_V(8); PG8_WAIT_L(0); PG8_BAR; PG8_MMA(1, 0, At, B0); PG8_MMA(1, 1, At, B1); PG8_BAR; PG8_SCHED;
            PG8_LDB(B0, 1, 0); PG8_LDB(B1, 1, 1); PG8_SCHED; PG8_LDA(At, 1, 0); PG8_STAGE(PG8_SA(0, 1), a2 + hstep, voffA);
            PG8_WAIT_V(8); PG8_WAIT_L(0); PG8_BAR; PG8_MMA(0, 0, At, B0); PG8_MMA(0, 1, At, B1); PG8_BAR; PG8_SCHED;
            PG8_LDA(At, 1, 1); PG8_STAGE(PG8_SB(1, 0), b3, voffB); PG8_STAGE(PG8_SB(1, 1), b3 + bhs, voffB); PG8_STAGE(PG8_SA(1, 0), a3, voffA);
            PG8_WAIT_V(8); PG8_WAIT_L(0); PG8_BAR; PG8_MMA(1, 0, At, B0); PG8_MMA(1, 1, At, B1); PG8_BAR; PG8_SCHED;
        }
        if (wr == 0) PG8_BAR;
        E(acc, cur, wr, wc, fr, fq); S.done(cur);
        if (!has_next) break;
#pragma unroll
        for (int a = 0; a < 2; ++a)
#pragma unroll
            for (int b = 0; b < 2; ++b)
#pragma unroll
                for (int m = 0; m < 4; ++m)
#pragma unroll
                    for (int n = 0; n < 2; ++n) acc[a][b][m][n] = (f32x4){0.f, 0.f, 0.f, 0.f};
        cur = nxt; cA = nA; cB = nB; ++ui;
        if (wr == 1) PG8_BAR;
    }
    PG8_WAIT_V(0);
    PG8_BAR;
#undef PG8_SA
#undef PG8_SB
#undef PG8_STAGE
#undef PG8_LDA
#undef PG8_LDB
#undef PG8_MMA
#undef PG8_WAIT_V
#undef PG8_WAIT_L
#undef PG8_BAR
#undef PG8_SCHED
}
template <class Epi, class Sched>
__device__ __forceinline__ void gemm_phase_gather(PG8_LAS unsigned char* lds, const Gemm g, const Sched& S, const Epi& E, const int tid, const int* rowidx) {
    const int wid = __builtin_amdgcn_readfirstlane(tid >> 6), lane = tid & 63, wr = wid >> 2, wc = wid & 3, fr = lane & 15, fq = lane >> 4;
    const int K = g.K, nt = K / BK;
    unsigned voffB[2]; int rowR[2]; unsigned colA[2];
#pragma unroll
    for (int i = 0; i < 2; ++i) { int R, C; stage_rc(tid * 16 + i * 8192, R, C); const int Rb = Epi::PERM ? ((R & ~31) + perm32(R & 31)) : R;
        rowR[i] = R; colA[i] = (unsigned)C * 2u; voffB[i] = (unsigned)(Rb * K + C) * 2u; }
    unsigned ocur[2][2], onxt[2][2], osel[2][2];
#define PG8_GOFF(dst, pm_) do { _Pragma("unroll") for (int _h = 0; _h < 2; ++_h) _Pragma("unroll") for (int _i = 0; _i < 2; ++_i) \
        dst[_h][_i] = (unsigned)rowidx[(pm_) * 256 + _h * 128 + rowR[_i]] * (unsigned)(K * 2) + colA[_i]; } while (0)
    const size_t kstep = (size_t)(BK * 2);
    const size_t hstep = (size_t)HALF * K * 2;
    const size_t tstep = 2 * hstep;
    const unsigned ldsw = (unsigned)wid * 1024u;
    const int aoff = lds_byte(wr * 64 + fr, fq * 8), boff = lds_byte(wc * 32 + fr, fq * 8);
#define PG8_SA(b, h) (((b) * 2 + (h)) * HTB)
#define PG8_SB(b, h) ((4 + (b) * 2 + (h)) * HTB)
#define PG8_STAGE(bufoff, gbase, voff) do { _Pragma("unroll") for (int _i = 0; _i < 2; ++_i) \
        __builtin_amdgcn_global_load_lds((const unsigned*)((const char*)(gbase) + (voff)[_i]), (PG8_LAS unsigned*)(lds + (bufoff) + ldsw + _i * 8192), 16, 0, 0); } while (0)
#define PG8_LDA(dst, b, h) do { _Pragma("unroll") for (int m = 0; m < 4; ++m) _Pragma("unroll") for (int k = 0; k < 2; ++k) dst[m][k] = *(const PG8_LAS bf16x8*)(lds + PG8_SA(b, h) + aoff + m * 2048 + k * 1024); } while (0)
#define PG8_LDB(dst, b, h) do { _Pragma("unroll") for (int n = 0; n < 2; ++n) _Pragma("unroll") for (int k = 0; k < 2; ++k) dst[n][k] = *(const PG8_LAS bf16x8*)(lds + PG8_SB(b, h) + boff + n * 2048 + k * 1024); } while (0)
#define PG8_MMA(ai, bj, At, Bt) do { __builtin_amdgcn_s_setprio(1); _Pragma("unroll") for (int m = 0; m < 4; ++m) _Pragma("unroll") for (int n = 0; n < 2; ++n) _Pragma("unroll") for (int k = 0; k < 2; ++k) \
        acc[ai][bj][m][n] = __builtin_amdgcn_mfma_f32_16x16x32_bf16(Bt[n][k], At[m][k], acc[ai][bj][m][n], 0, 0, 0); __builtin_amdgcn_s_setprio(0); } while (0)
#define PG8_WAIT_V(n) asm volatile("s_waitcnt vmcnt(" #n ")" ::: "memory")
#define PG8_WAIT_L(n) asm volatile("s_waitcnt lgkmcnt(" #n ")" ::: "memory")
#define PG8_BAR __builtin_amdgcn_s_barrier()
#define PG8_SCHED __builtin_amdgcn_sched_barrier(0)
    Unit cur, nxt; int ui = 0;
    if (!S.next(0, cur)) return;
    f32x4 acc[2][2][4][2];
#pragma unroll
    for (int a = 0; a < 2; ++a)
#pragma unroll
        for (int b = 0; b < 2; ++b)
#pragma unroll
            for (int m = 0; m < 4; ++m)
#pragma unroll
                for (int n = 0; n < 2; ++n) acc[a][b][m][n] = (f32x4){0.f, 0.f, 0.f, 0.f};
    bf16x8 At[4][2], B0[2][2], B1[2][2];
    const char* cA = (const char*)g.A; const char* cB = (const char*)g.Bt + (size_t)cur.pn * tstep;
    S.a_ready(cur);
    PG8_GOFF(ocur, cur.pm);
#pragma unroll
    for (int _h = 0; _h < 2; ++_h)
#pragma unroll
        for (int _i = 0; _i < 2; ++_i) onxt[_h][_i] = ocur[_h][_i];
    PG8_STAGE(PG8_SB(0, 0), cB, voffB); PG8_STAGE(PG8_SB(0, 1), cB + hstep, voffB); PG8_STAGE(PG8_SA(0, 0), cA, ocur[0]); PG8_STAGE(PG8_SA(0, 1), cA, ocur[1]);
    if (wr == 1) PG8_BAR;
    PG8_WAIT_V(2); PG8_BAR;
    PG8_STAGE(PG8_SB(1, 0), cB + kstep, voffB); PG8_STAGE(PG8_SA(1, 0), cA + kstep, ocur[0]); PG8_STAGE(PG8_SB(1, 1), cB + hstep + kstep, voffB);
    PG8_WAIT_V(6); PG8_BAR;
    for (;;) {
        const bool has_next = S.next(ui + 1, nxt);
        const char* nA = cA; const char* nB = has_next ? (const char*)g.Bt + (size_t)nxt.pn * tstep : cB;
        if (has_next) PG8_GOFF(onxt, nxt.pm);
        for (int t = 0; t < nt; t += 2) {
            const bool last = (t == nt - 2);
            const char* a1 = cA + (size_t)(t + 1) * kstep;
            const char* a2 = last ? nA : cA + (size_t)(t + 2) * kstep; const char* b2 = last ? nB : cB + (size_t)(t + 2) * kstep;
            const char* a3 = a2 + kstep; const char* b3 = b2 + kstep;
            if (last && has_next) S.a_ready(nxt);
#pragma unroll
            for (int _h = 0; _h < 2; ++_h)
#pragma unroll
                for (int _i = 0; _i < 2; ++_i) osel[_h][_i] = (last && has_next) ? onxt[_h][_i] : ocur[_h][_i];
            PG8_LDB(B0, 0, 0); PG8_LDB(B1, 0, 1); PG8_SCHED; PG8_LDA(At, 0, 0); PG8_STAGE(PG8_SA(1, 1), a1, ocur[1]);
            PG8_WAIT_V(8); PG8_WAIT_L(0); PG8_BAR; PG8_MMA(0, 0, At, B0); PG8_MMA(0, 1, At, B1); PG8_BAR; PG8_SCHED;
            PG8_LDA(At, 0, 1); PG8_STAGE(PG8_SB(0, 0), b2, voffB); PG8_STAGE(PG8_SB(0, 1), b2 + hstep, voffB); PG8_STAGE(PG8_SA(0, 0), a2, osel[0]);
            PG8_WAIT_V(8); PG8_WAIT_L(0); PG8_BAR; PG8_MMA(1, 0, At, B0); PG8_MMA(1, 1, At, B1); PG8_BAR; PG8_SCHED;
            PG8_LDB(B0, 1, 0); PG8_LDB(B1, 1, 1); PG8_SCHED; PG8_LDA(At, 1, 0); PG8_STAGE(PG8_SA(0, 1), a2, osel[1]);
            PG8_WAIT_V(8); PG8_WAIT_L(0); PG8_BAR; PG8_MMA(0, 0, At, B0); PG8_MMA(0, 1, At, B1); PG8_BAR; PG8_SCHED;
            PG8_LDA(At, 1, 1); PG8_STAGE(PG8_SB(1, 0), b3, voffB); PG8_STAGE(PG8_SB(1, 1), b3 + hstep, voffB); PG8_STAGE(PG8_SA(1, 0), a3, osel[0]);
            PG8_WAIT_V(8); PG8_WAIT_L(0); PG8_BAR; PG8_MMA(1, 0, At, B0); PG8_MMA(1, 1, At, B1); PG8_BAR; PG8_SCHED;
        }
        if (wr == 0) PG8_BAR;
        E(acc, cur, wr, wc, fr, fq); S.done(cur);
        if (!has_next) break;
#pragma unroll
        for (int a = 0; a < 2; ++a)
#pragma unroll
            for (int b = 0; b < 2; ++b)
#pragma unroll
                for (int m = 0; m < 4; ++m)
#pragma unroll
                    for (int n = 0; n < 2; ++n) acc[a][b][m][n] = (f32x4){0.f, 0.f, 0.f, 0.f};
        cur = nxt; cB = nB; ++ui;
        if (wr == 1) PG8_BAR;
#pragma unroll
        for (int _h = 0; _h < 2; ++_h)
#pragma unroll
            for (int _i = 0; _i < 2; ++_i) ocur[_h][_i] = onxt[_h][_i];
    }
    PG8_WAIT_V(0);
    PG8_BAR;
#undef PG8_GOFF
#undef PG8_SA
#undef PG8_SB
#undef PG8_STAGE
#undef PG8_LDA
#undef PG8_LDB
#undef PG8_MMA
#undef PG8_WAIT_V
#undef PG8_WAIT_L
#undef PG8_BAR
#undef PG8_SCHED
}
}

#define XB_TMO      128
#define XB_XCNT(j)  (256  + 64 * (j))
#define XB_XSUB(j)  (1280 + 64 * (j))
#define XB_XGEN(j)  (2304 + 64 * (j))
#define XB_TOP      3328
#define XB_TOPGEN   3392
#define XCD_BAR_WORDS 3456
#define XB_SPIN_CAP (1u << 21)
#define LAS __attribute__((address_space(3)))

__device__ __forceinline__ unsigned xb_ld(unsigned* p)              { return __hip_atomic_load(p, __ATOMIC_RELAXED, __HIP_MEMORY_SCOPE_AGENT); }
__device__ __forceinline__ unsigned xb_add(unsigned* p, unsigned v) { return __hip_atomic_fetch_add(p, v, __ATOMIC_RELAXED, __HIP_MEMORY_SCOPE_AGENT); }
__device__ __forceinline__ unsigned xb_xcc_id() { return (unsigned)__builtin_amdgcn_s_getreg((3 << 11) | 20) & 0xFu; }
#define XB_SPIN(cond, bar) do { unsigned _sp = 0; while (cond) { __builtin_amdgcn_s_sleep(1); \
    if ((++_sp & 255u) == 0u) { if (xb_ld(&(bar)[XB_TMO])) break; if (_sp > XB_SPIN_CAP) { atomicAdd(&(bar)[XB_TMO], 1u); break; } } } } while (0)

struct XcdBarrier { unsigned* bar; unsigned x; volatile LAS unsigned* st; };

__device__ __forceinline__ XcdBarrier xcd_barrier_post(unsigned* bar, volatile LAS unsigned* st, bool t0) {
    XcdBarrier b; b.bar = bar; b.x = xb_xcc_id(); b.st = st;
    if (t0) (void)xb_add(&bar[XB_XCNT(b.x)], 1u);
    return b;
}
__device__ __forceinline__ void xcd_barrier_complete(unsigned* bar, unsigned x, unsigned& nloc, unsigned& nx) {
    const unsigned G = gridDim.x * gridDim.y * gridDim.z;
    unsigned sum, cnt, mine, sp = 0u;
    for (;;) {
        sum = 0u; cnt = 0u; mine = 0u;
#pragma unroll
        for (unsigned j = 0; j < 16; ++j) { const unsigned c = xb_ld(&bar[XB_XCNT(j)]); sum += c; cnt += (c > 0u) ? 1u : 0u; mine = (j == x) ? c : mine; }
        if (sum == G) break;
        __builtin_amdgcn_s_sleep(1);
        if ((++sp & 255u) == 0u) { if (xb_ld(&bar[XB_TMO])) break; if (sp > XB_SPIN_CAP) { atomicAdd(&bar[XB_TMO], 1u); break; } }
    }
    nloc = mine > 0u ? mine : 1u; nx = cnt > 0u ? cnt : 1u;
}
__device__ __forceinline__ void xcd_barrier(const XcdBarrier& b, bool t0) {
    asm volatile("s_waitcnt vmcnt(0)" ::: "memory");
    __syncthreads();
    if (t0) {
        unsigned* bar = b.bar;
        __builtin_amdgcn_s_waitcnt(0);
        unsigned nloc = b.st[0], nx = b.st[1];
        if (nloc == 0u) { xcd_barrier_complete(bar, b.x, nloc, nx); b.st[0] = nloc; b.st[1] = nx; }
        const unsigned old = xb_add(&bar[XB_XSUB(b.x)], 1u);
        const unsigned gen = old / nloc;
        if (old + 1u == (gen + 1u) * nloc) {
            __builtin_amdgcn_fence(__ATOMIC_RELEASE, "agent");
            asm volatile("s_waitcnt vmcnt(0)" ::: "memory");
            const unsigned og = xb_add(&bar[XB_TOP], 1u);
            const unsigned tg = og / nx;
            if (og + 1u == (tg + 1u) * nx) xb_add(&bar[XB_TOPGEN], 1u);
            else XB_SPIN(xb_ld(&bar[XB_TOPGEN]) == tg, bar);
            __builtin_amdgcn_fence(__ATOMIC_ACQUIRE, "agent");
            xb_add(&bar[XB_XGEN(b.x)], 1u);
            asm volatile("s_waitcnt vmcnt(0)" ::: "memory");
        } else {
            XB_SPIN(xb_ld(&bar[XB_XGEN(b.x)]) == gen, bar);
            __builtin_amdgcn_fence(__ATOMIC_ACQUIRE, "agent");
            asm volatile("s_waitcnt vmcnt(0)" ::: "memory");
        }
    }
    __syncthreads();
}

typedef unsigned short bf16_t;
typedef float f32x4 __attribute__((ext_vector_type(4)));
typedef unsigned u32x4 __attribute__((ext_vector_type(4)));
typedef unsigned u32x2 __attribute__((ext_vector_type(2)));

constexpr int D = 1024, NB = 16, SEQ = 4096, CTXL = 256, DEPTH = 4;
constexpr int NLAT = NB * SEQ, NCTX = NB * CTXL, NROW = NLAT + NCTX;
constexpr int CONV_CH = 2560, NPROJ = 3616, NPROJ_PAD = 3840;
constexpr int FST = 128;
#define FADDR(R, col) ((((size_t)((col) >> 7)) * NROW + (size_t)(R)) * FST + ((col) & 127))
#define OADDR(R, col) ((((size_t)(R) >> 1) * 32 + ((col) >> 5)) * 64 + ((size_t)(R) & 1) * 32 + ((col) & 31))
constexpr int NMOD = 6 * D;
constexpr size_t MiB = (size_t)1 << 20;
constexpr size_t WS_CTL = 0, WS_ZROW = 65536, WS_CWT = 131072  , WS_MOD = 1 * MiB, WS_CTXR = 3 * MiB, WS_AFF = 19 * MiB, WS_RSTD = 24 * MiB, WS_SELT = 25 * MiB, WS_SELG = 26 * MiB, WS_SLOT = 27 * MiB;
constexpr size_t WS_WIN = 32 * MiB, WS_WOUT = 40 * MiB, WS_WGU = 42 * MiB, WS_WD = 74 * MiB, WS_SM = 90 * MiB;
constexpr size_t WS_F = 100 * MiB, WS_PR = 440 * MiB, WS_OD = 576 * MiB, WS_TQ = 848 * MiB, WS_SCL = 984 * MiB, WS_CB = 995 * MiB, WS_END = 1012 * MiB;
constexpr size_t WS_PC = WS_OD, WS_H = WS_F, WS_MIX = WS_TQ, WS_M = WS_F, WS_H2 = 236 * MiB, WS_HID = WS_PR, WS_YE = WS_OD, WS_XL = WS_TQ;
constexpr int LDS_BYTES = 155648, LDS_XB_OFF = 155392;
constexpr float EPS = 1e-6f;

struct Params {
    const float *x, *c, *ctx, *c_ctx, *ada_w, *ada_b, *norm_g, *w_in, *conv_w, *conv_b, *dn_A_log, *dn_dt_bias, *dn_norm_g, *ssm_A_log, *ssm_dt_bias, *ssm_D, *ssm_norm_g, *w_out, *router_w, *w_gate, *w_up, *w_down;
    float* out; unsigned char* ws;
};

__device__ __forceinline__ float bf2f(unsigned short b) { return __uint_as_float(((unsigned)b) << 16); }
__device__ __forceinline__ unsigned short f2bf(float f) { unsigned u = __float_as_uint(f); u += 0x7FFFu + ((u >> 16) & 1u); return (unsigned short)(u >> 16); }
typedef __bf16 bf16x2_t __attribute__((ext_vector_type(2)));
typedef float f32x2_t __attribute__((ext_vector_type(2)));
__device__ __forceinline__ unsigned pk2(float lo, float hi) { f32x2_t v = {lo, hi}; return __builtin_bit_cast(unsigned, __builtin_convertvector(v, bf16x2_t)); }
__device__ __forceinline__ float lo_bf(unsigned w) { return __uint_as_float(w << 16); }
__device__ __forceinline__ float hi_bf(unsigned w) { return __uint_as_float(w & 0xFFFF0000u); }
__device__ __forceinline__ float silu_f(float t) { return t * __builtin_amdgcn_rcpf(1.f + __expf(-t)); }
__device__ __forceinline__ float sigmoid_f(float t) { return __builtin_amdgcn_rcpf(1.f + __expf(-t)); }
__device__ __forceinline__ float softplus_f(float t) { const float e = __expf(t); return t > 20.f ? t : (t < -10.f ? e : __logf(1.f + e)); }
template <int O> __device__ __forceinline__ float sxor(float v) { return __int_as_float(__builtin_amdgcn_ds_swizzle(__float_as_int(v), 0x1F | (O << 10))); }
template <int O> __device__ __forceinline__ int sxor_i(int v) { return __builtin_amdgcn_ds_swizzle(v, 0x1F | (O << 10)); }
__device__ __forceinline__ float lane_get(float v, int src_lane) { return __int_as_float(__builtin_amdgcn_ds_bpermute(src_lane << 2, __float_as_int(v))); }
__device__ __forceinline__ int lane_get_i(int v, int src_lane) { return __builtin_amdgcn_ds_bpermute(src_lane << 2, v); }
template <int CTRL> __device__ __forceinline__ float dppf(float v) { return __int_as_float(__builtin_amdgcn_update_dpp(0, __float_as_int(v), CTRL, 0xF, 0xF, true)); }
template <int CTRL> __device__ __forceinline__ int dppi(int v) { return __builtin_amdgcn_update_dpp(0, v, CTRL, 0xF, 0xF, true); }
__device__ __forceinline__ float wave_sum(float v, int lane) {
    v += dppf<0xB1>(v); v += dppf<0x4E>(v); v += dppf<0x141>(v); v += dppf<0x140>(v); v += sxor<16>(v); v += lane_get(v, lane ^ 32);
    return v;
}
__device__ __forceinline__ int wave_sum_i(int v, int lane) {
    v += dppi<0xB1>(v); v += dppi<0x4E>(v); v += dppi<0x141>(v); v += dppi<0x140>(v); v += sxor_i<16>(v); v += lane_get_i(v, lane ^ 32);
    return v;
}
__device__ __forceinline__ float wave_incl_scan(float x, int lane) {
#pragma unroll
    for (int o = 1; o < 64; o <<= 1) { const float t = lane_get(x, lane >= o ? lane - o : lane); if (lane >= o) x += t; }
    return x;
}
__device__ __forceinline__ int wave_incl_scan_i(int x, int lane) {
#pragma unroll
    for (int o = 1; o < 64; o <<= 1) { const int t = lane_get_i(x, lane >= o ? lane - o : lane); if (lane >= o) x += t; }
    return x;
}

__device__ __forceinline__ void phase_mods(const Params& p, unsigned char* smem, const int tid, const int bid, const int nblk) {
    float* s_lds = (float*)smem;
    float* red = s_lds + 17 * 1024;
    if (bid >= 192) return;
    for (int i = tid; i < 17 * 1024; i += 512) { const int r = i >> 10, k = i & 1023; const float v = r < 16 ? p.c[r * 1024 + k] : p.c_ctx[k]; s_lds[i] = silu_f(v); }
    __syncthreads();
    float* mod = (float*)(p.ws + WS_MOD);
    for (int it = bid; it < 192; it += nblk) {
        const int l = it / 48, cg = it % 48, jj = tid & 127, kq = tid >> 7, j = cg * 128 + jj;
        float acc[17];
#pragma unroll
        for (int r = 0; r < 17; ++r) acc[r] = 0.f;
        const float* w = p.ada_w + ((size_t)l * 1024 + kq * 256) * NMOD + j;
        const float* sl = s_lds + kq * 256;
#pragma unroll 8
        for (int k = 0; k < 256; ++k) { const float wv = w[(size_t)k * NMOD];
#pragma unroll
            for (int r = 0; r < 17; ++r) acc[r] += sl[r * 1024 + k] * wv; }
#pragma unroll
        for (int r = 0; r < 17; ++r) red[(kq * 17 + r) * 128 + jj] = acc[r];
        __syncthreads();
        for (int i = tid; i < 17 * 128; i += 512) { const int r = i >> 7, j2 = i & 127;
            const float s = red[(0 * 17 + r) * 128 + j2] + red[(1 * 17 + r) * 128 + j2] + red[(2 * 17 + r) * 128 + j2] + red[(3 * 17 + r) * 128 + j2] + p.ada_b[l * NMOD + cg * 128 + j2];
            mod[((size_t)l * 17 + r) * NMOD + cg * 128 + j2] = s; }
        __syncthreads();
    }
}

__device__ __forceinline__ void wconv_item(const float* src, int K, int N, bool real, int k0, int n0, bf16_t* dst, size_t dst_row0, float* scr, int lane) {
    if (real) {
        f32x4 wv[8];
#pragma unroll
        for (int i = 0; i < 8; ++i) wv[i] = *(const f32x4*)(src + (size_t)(k0 + 8 * i + (lane >> 3)) * N + n0 + 4 * (lane & 7));
#pragma unroll
        for (int i = 0; i < 8; ++i) { float* s_ = scr + (8 * i + (lane >> 3)) * 33 + 4 * (lane & 7); s_[0] = wv[i].x; s_[1] = wv[i].y; s_[2] = wv[i].z; s_[3] = wv[i].w; }
    }
    asm volatile("s_waitcnt lgkmcnt(0)" ::: "memory");
    const int c = lane & 7;
#pragma unroll
    for (int j = 0; j < 4; ++j) { const int n = (lane >> 3) + 8 * j; const float* q = scr + (8 * c) * 33 + n;
        u32x4 o;
        if (real) { o.x = pk2(q[0 * 33], q[1 * 33]); o.y = pk2(q[2 * 33], q[3 * 33]); o.z = pk2(q[4 * 33], q[5 * 33]); o.w = pk2(q[6 * 33], q[7 * 33]); }
        else { unsigned z = 0u; asm volatile("" : "+v"(z)); o = (u32x4){z, z, z, z}; }
        *(u32x4*)(dst + (dst_row0 + n) * (size_t)K + k0 + 8 * c) = o; }
    asm volatile("s_waitcnt lgkmcnt(0)" ::: "memory");
}
constexpr int WCONV_SPLIT = 4608;
__device__ __forceinline__ void phase_wconv(const Params& p, int l, unsigned char* smem, const int tid, const int bid, const int nblk, const int part, const int wave0) {
    const int lane = tid & 63, wid = __builtin_amdgcn_readfirstlane(tid >> 6), gw = wave0 == -2 ? bid * 6 + wid - 2 : bid * 8 + wid - wave0, NGW = wave0 == -2 ? nblk * 6 : nblk * 8 - wave0;
    if (gw < 0 || (wave0 == -2 && wid < 2)) return;
    float* scr = (float*)(smem + (wave0 == -2 ? 32768 : 0) + (size_t)wid * 8704);
    bf16_t* Win = (bf16_t*)(p.ws + WS_WIN); bf16_t* Wout = (bf16_t*)(p.ws + WS_WOUT); bf16_t* Wgu = (bf16_t*)(p.ws + WS_WGU); bf16_t* Wd = (bf16_t*)(p.ws + WS_WD);
    constexpr int T_IN = 16 * 120, T_OUT = 16 * 32, T_G = 16 * 256, T_U = 16 * 256, T_D = 16 * 256, T_ALL = T_IN + T_OUT + T_G + T_U + T_D;
    const int it_lo = (part == 1 || part == 2) ? T_IN + T_OUT : (part == 3 ? T_IN + T_OUT + WCONV_SPLIT : 0), it_hi = (part == 0) ? T_IN + T_OUT : (part == 2 ? T_IN + T_OUT + WCONV_SPLIT : T_ALL);
    for (int it = it_lo + gw; it < it_hi; it += NGW) {
        int r = it;
        if (r < T_IN) { const int kt = r / 120, nt = r % 120; wconv_item(p.w_in + (size_t)l * D * NPROJ, D, NPROJ, nt * 32 < NPROJ, kt * 64, nt * 32, Win, (size_t)nt * 32, scr, lane); continue; }
        r -= T_IN;
        if (r < T_OUT) { const int kt = r / 32, nt = r % 32; wconv_item(p.w_out + (size_t)l * D * D, D, D, true, kt * 64, nt * 32, Wout, (size_t)nt * 32, scr, lane); continue; }
        r -= T_OUT;
        if (r < T_G + T_U) { const int up = r >= T_G; if (up) r -= T_G; const int e = r / 256, q = r % 256, kt = q / 16, nt = q % 16;
            const float* src = (up ? p.w_up : p.w_gate) + ((size_t)l * 16 + e) * D * 512;
            const int n0 = nt * 32, j = n0 >> 7, cc = n0 & 127;
            wconv_item(src, D, 512, true, kt * 64, n0, Wgu, (size_t)e * 1024 + j * 256 + (up ? 128 : 0) + cc, scr, lane); continue; }
        r -= T_G + T_U;
        { const int e = r / 256, q = r % 256, kt = q / 32, nt = q % 32;
            const float* src = p.w_down + ((size_t)l * 16 + e) * 512 * D;
            wconv_item(src, 512, D, true, kt * 64, nt * 32, Wd, (size_t)e * 1024 + nt * 32, scr, lane); }
    }
}

__device__ __forceinline__ int row_modr(int R) { return R < NLAT ? (R >> 12) : 16; }
__device__ __forceinline__ const float* xres_in(const Params& p, int l, int R) {
    if (l == 0) return R < NLAT ? p.x + (size_t)R * D : p.ctx + (size_t)(R - NLAT) * D;
    return R < NLAT ? p.out + (size_t)R * D : (const float*)(p.ws + WS_CTXR) + (size_t)(R - NLAT) * D;
}
__device__ __forceinline__ bf16_t* xb_ptr(const Params& p, int R) { return R < NLAT ? (bf16_t*)p.out + (size_t)R * D : (bf16_t*)(p.ws + WS_CTXR) + (size_t)(R - NLAT) * D; }
__device__ __forceinline__ bf16_t* xl_ptr(const Params& p, int R) { return (bf16_t*)(p.ws + WS_XL) + (size_t)R * D; }
__device__ __forceinline__ f32x4 unpack4(const u32x2 t) { return (f32x4){lo_bf(t.x), hi_bf(t.x), lo_bf(t.y), hi_bf(t.y)}; }

__device__ __forceinline__ void prenorm_row(const f32x4 (&xv)[4], float rstd, const float* g, const float* shift, const float* scale, bf16_t* hrow, int lane) {
#pragma unroll
    for (int j = 0; j < 4; ++j) { const int i = 256 * j + 4 * lane;
        const f32x4 gv = *(const f32x4*)(g + i), sh = *(const f32x4*)(shift + i), sc = *(const f32x4*)(scale + i);
        const f32x4 h = xv[j] * rstd * gv * (sc + 1.f) + sh;
        u32x2 o; o.x = pk2(h.x, h.y); o.y = pk2(h.z, h.w);
        *(u32x2*)(hrow + i) = o; }
}

__device__ __forceinline__ void phase_h0(const Params& p, const int tid, const int bid, const int nblk) {
    const int lane = tid & 63, gw = bid * 8 + (tid >> 6), NGW = nblk * 8;
    bf16_t* H = (bf16_t*)(p.ws + WS_H); const float* mod = (const float*)(p.ws + WS_MOD);
    for (int R0 = 2 * gw; R0 < NROW; R0 += 2 * NGW) {
        f32x4 xv[2][4];
#pragma unroll
        for (int k = 0; k < 2; ++k) { const float* xr = xres_in(p, 0, R0 + k);
#pragma unroll
            for (int j = 0; j < 4; ++j) xv[k][j] = *(const f32x4*)(xr + 256 * j + 4 * lane); }
#pragma unroll
        for (int k = 0; k < 2; ++k) { const int R = R0 + k; const float* md = mod + (size_t)(0 * 17 + row_modr(R)) * NMOD; float ss = 0.f;
#pragma unroll
            for (int j = 0; j < 4; ++j) ss += xv[k][j].x * xv[k][j].x + xv[k][j].y * xv[k][j].y + xv[k][j].z * xv[k][j].z + xv[k][j].w * xv[k][j].w;
            const float rstd = rsqrtf(wave_sum(ss, lane) * (1.f / D) + EPS);
            prenorm_row(xv[k], rstd, p.norm_g + 0, md + 0, md + D, H + (size_t)R * D, lane); }
    }
}

template <bool NT> __device__ __forceinline__ void store_wide(bf16_t* base, size_t stride, const u32x4 w0, const u32x4 w1, int fr, int fq) {
    const bool hi = (fr & 8) != 0;
    u32x4 X, Y, d1, d2;
    X.x = hi ? w0.x : w1.x; X.y = hi ? w0.y : w1.y; X.z = hi ? w0.z : w1.z; X.w = hi ? w0.w : w1.w;
    Y.x = (unsigned)dppi<0x128>((int)X.x); Y.y = (unsigned)dppi<0x128>((int)X.y); Y.z = (unsigned)dppi<0x128>((int)X.z); Y.w = (unsigned)dppi<0x128>((int)X.w);
    d1.x = hi ? Y.x : w0.x; d1.y = hi ? Y.y : w0.y; d1.z = hi ? Y.z : w0.z; d1.w = hi ? Y.w : w0.w;
    d2.x = hi ? w1.x : Y.x; d2.y = hi ? w1.y : Y.y; d2.z = hi ? w1.z : Y.z; d2.w = hi ? w1.w : Y.w;
    bf16_t* q = base + (size_t)(fr & 7) * stride + (hi ? 32 : 0) + 8 * fq;
    if (NT) { __builtin_nontemporal_store(d1, (u32x4*)q); __builtin_nontemporal_store(d2, (u32x4*)(q + 8 * stride)); }
    else { *(u32x4*)q = d1; *(u32x4*)(q + 8 * stride) = d2; }
}
__device__ __forceinline__ u32x4 pack_acc(const pg8::f32x4 v0, const pg8::f32x4 v1) {
    u32x4 w; w.x = pg8::cvt_pk_bf16(v0[0], v0[1]); w.y = pg8::cvt_pk_bf16(v0[2], v0[3]); w.z = pg8::cvt_pk_bf16(v1[0], v1[1]); w.w = pg8::cvt_pk_bf16(v1[2], v1[3]); return w; }
struct EpiInProj {
    static constexpr bool PERM = true, WIDE = true;
    bf16_t* PC; bf16_t* PR; float* SM;
    __device__ __forceinline__ void operator()(const pg8::f32x4 (&acc)[2][2][4][2], const pg8::Unit& u, int wr, int wc, int fr, int fq) const {
        const int rowb = u.pm * 256 + wr * 64;
        if (u.pn < 14) {
            bf16_t* base; size_t stride;
            if (u.pn < 10) { base = PC + ((size_t)(u.pn >> 1) * NROW) * 512 + (u.pn & 1) * 256 + 64 * wc; stride = 512; }
            else { base = PR + (u.pn - 10) * 256 + 64 * wc; stride = 1024; }
#pragma unroll
            for (int ai = 0; ai < 2; ++ai)
#pragma unroll
                for (int m = 0; m < 4; ++m)
                    store_wide<true>(base + (size_t)(rowb + ai * 128 + m * 16) * stride, stride, pack_acc(acc[ai][0][m][0], acc[ai][0][m][1]), pack_acc(acc[ai][1][m][0], acc[ai][1][m][1]), fr, fq);
        } else if (wc == 0) {
#pragma unroll
            for (int ai = 0; ai < 2; ++ai)
#pragma unroll
                for (int m = 0; m < 4; ++m) { float* d = SM + (size_t)(8 * fq) * NROW + (rowb + ai * 128 + m * 16 + fr);
#pragma unroll
                    for (int e = 0; e < 4; ++e) { d[(size_t)e * NROW] = acc[ai][0][m][0][e]; d[(size_t)(4 + e) * NROW] = acc[ai][0][m][1][e]; } }
        }
    }
};
struct EpiPlain {
    static constexpr bool PERM = true, WIDE = true;
    bf16_t* O;
    __device__ __forceinline__ void operator()(const pg8::f32x4 (&acc)[2][2][4][2], const pg8::Unit& u, int wr, int wc, int fr, int fq) const {
        bf16_t* base = O + (size_t)(u.pm * 256 + wr * 64) * 1024 + u.pn * 256 + 64 * wc;
#pragma unroll
        for (int ai = 0; ai < 2; ++ai)
#pragma unroll
            for (int m = 0; m < 4; ++m)
                store_wide<false>(base + (size_t)(ai * 128 + m * 16) * 1024, 1024, pack_acc(acc[ai][0][m][0], acc[ai][0][m][1]), pack_acc(acc[ai][1][m][0], acc[ai][1][m][1]), fr, fq);
    }
};
struct EpiSwiGLU {
    static constexpr bool PERM = true, WIDE = false;
    bf16_t* HID;
    __device__ __forceinline__ void operator()(const pg8::f32x4 (&acc)[2][2][4][2], const pg8::Unit& u, int wr, int wc, int fr, int fq) const {
        const int row0 = u.pm * 256 + wr * 64 + fr, col0 = (u.pn & 3) * 128 + wc * 32 + 8 * fq;
#pragma unroll
        for (int ai = 0; ai < 2; ++ai)
#pragma unroll
            for (int m = 0; m < 4; ++m) { bf16_t* rowp = HID + (size_t)(row0 + ai * 128 + m * 16) * 512 + col0;
                const pg8::f32x4 g0 = acc[ai][0][m][0], g1 = acc[ai][0][m][1], u0 = acc[ai][1][m][0], u1 = acc[ai][1][m][1];
                u32x4 w; w.x = pg8::cvt_pk_bf16(silu_f(g0[0]) * u0[0], silu_f(g0[1]) * u0[1]); w.y = pg8::cvt_pk_bf16(silu_f(g0[2]) * u0[2], silu_f(g0[3]) * u0[3]);
                w.z = pg8::cvt_pk_bf16(silu_f(g1[0]) * u1[0], silu_f(g1[1]) * u1[1]); w.w = pg8::cvt_pk_bf16(silu_f(g1[2]) * u1[2], silu_f(g1[3]) * u1[3]);
                *(u32x4*)rowp = w; }
    }
};
struct EpiDown {
    static constexpr bool PERM = true, WIDE = true;
    bf16_t* YE; const float* gate;
    __device__ __forceinline__ void operator()(const pg8::f32x4 (&acc)[2][2][4][2], const pg8::Unit& u, int wr, int wc, int fr, int fq) const {
        const int rowb = u.pm * 256 + wr * 64; bf16_t* base = YE + (size_t)rowb * 1024 + (u.pn & 3) * 256 + 64 * wc;
        float gts[2][4];
#pragma unroll
        for (int ai = 0; ai < 2; ++ai)
#pragma unroll
            for (int m = 0; m < 4; ++m) gts[ai][m] = gate[rowb + ai * 128 + m * 16 + fr];
        asm volatile("" ::: "memory");
#pragma unroll
        for (int ai = 0; ai < 2; ++ai)
#pragma unroll
            for (int m = 0; m < 4; ++m) { const float gt = gts[ai][m];
                store_wide<true>(base + (size_t)(ai * 128 + m * 16) * 1024, 1024, pack_acc(acc[ai][0][m][0] * gt, acc[ai][0][m][1] * gt), pack_acc(acc[ai][1][m][0] * gt, acc[ai][1][m][1] * gt), fr, fq); }
    }
};

typedef short s16x8c __attribute__((ext_vector_type(8)));
typedef __bf16 bf16x8c_t __attribute__((ext_vector_type(8)));
typedef float f32x8c_t __attribute__((ext_vector_type(8)));
__device__ __forceinline__ s16x8c cvt8c(float a0, float a1, float a2, float a3, float a4, float a5, float a6, float a7) {
    f32x8c_t v = {a0, a1, a2, a3, a4, a5, a6, a7}; return __builtin_bit_cast(s16x8c, __builtin_convertvector(v, bf16x8c_t)); }
typedef float f32x2c __attribute__((ext_vector_type(2)));
__device__ __forceinline__ void phase_conv(const Params& p, int l, const int tid, const int bid, const int nblk) {
    const int lane = tid & 63, wid = __builtin_amdgcn_readfirstlane(tid >> 6), gw = bid * 8 + wid, NGW = nblk * 8;
    const bf16_t* PC = (const bf16_t*)(p.ws + WS_PC); bf16_t* F = (bf16_t*)(p.ws + WS_F);
    const int WX = (nblk >> 3) * 8, wx = (bid >> 3) * 8 + wid, xcd = bid & 7; const bool banded = (nblk & 7) == 0;
    const int NFULL = (5440 / NGW) * NGW, NSLOT = NFULL + 3 * (5440 - NFULL);
    for (int rnd = 0; ; ++rnd) {
        const int sl0 = banded ? (rnd * 8 + xcd) * WX + wx : rnd * NGW + gw;
        if (banded ? (rnd * 8 * WX >= NSLOT) : (sl0 >= NSLOT)) break;
        if (sl0 >= NSLOT) continue;
        const int it0 = sl0 < NFULL ? sl0 : NFULL + (sl0 - NFULL) / 3, seg = sl0 < NFULL ? -1 : (sl0 - NFULL) % 3;
        const int cbeg = seg <= 0 ? 0 : (seg == 1 ? 7 : 14), npairs = seg < 0 ? 11 : 4, ofirst = seg <= 0 ? 0 : (seg == 1 ? 22 : 43);
        const int it = 5439 - it0;
        const int cg = it % 5, ri = it / 5, ch = cg * 512 + lane * 8;
        f32x2c w2[4][9], bias2[4];
        { const float* wt = (const float*)(p.ws + WS_CWT) + (size_t)l * 9 * CONV_CH + ch;
#pragma unroll
            for (int t = 0; t < 9; ++t) { const f32x4 wa = *(const f32x4*)(wt + (size_t)t * CONV_CH), wb = *(const f32x4*)(wt + (size_t)t * CONV_CH + 4);
                w2[0][t] = (f32x2c){wa.x, wa.y}; w2[1][t] = (f32x2c){wa.z, wa.w}; w2[2][t] = (f32x2c){wb.x, wb.y}; w2[3][t] = (f32x2c){wb.z, wb.w}; }
            const f32x4* bp = (const f32x4*)(p.conv_b + (size_t)l * CONV_CH + ch); const f32x4 b0 = bp[0], b1 = bp[1];
            bias2[0] = (f32x2c){b0.x, b0.y}; bias2[1] = (f32x2c){b0.z, b0.w}; bias2[2] = (f32x2c){b1.x, b1.y}; bias2[3] = (f32x2c){b1.z, b1.w}; }
        long rb0, rb1, rb2; bool v0, v2; int lo, hi, start;
        if (ri < 1024) { const int b = ri >> 6, r = ri & 63; rb1 = (long)b * 4096 + r * 64; v0 = r > 0; v2 = r < 63; rb0 = v0 ? rb1 - 64 : rb1; rb2 = v2 ? rb1 + 64 : rb1; lo = 0; hi = 64; start = 0; }
        else { const int ci = ri - 1024, b = ci >> 2, s = ci & 3; rb1 = (long)NLAT + b * 256; rb0 = rb1; rb2 = rb1; v0 = false; v2 = false; lo = 0; hi = 256; start = s * 64; }
        const bf16_t* PCl = PC + (size_t)cg * NROW * 512 + lane * 8;
        bf16_t* Fl = F + FADDR(0, ch);
        f32x2c a0[4], a1[4], a2[4];
#pragma unroll
        for (int k = 0; k < 4; ++k) { a0[k] = (f32x2c){0.f, 0.f}; a1[k] = a0[k]; a2[k] = a0[k]; }
#define CONV_LOAD(L, CH) do { _Pragma("unroll") for (int q = 0; q < 3; ++q) { const int cc = start - 1 + (CH) * 3 + q; const int ccl = cc < lo ? lo : (cc >= hi ? hi - 1 : cc);        \
                L[q][0] = *(const u32x4*)(PCl + (size_t)(rb0 + ccl) * 512); \
                L[q][1] = *(const u32x4*)(PCl + (size_t)(rb1 + ccl) * 512); \
                L[q][2] = *(const u32x4*)(PCl + (size_t)(rb2 + ccl) * 512); } } while (0)
#define CONV_COL(L, CH, q, P, C, N) do { const int cc = start - 1 + (CH) * 3 + (q); \
                _Pragma("unroll") for (int i = 0; i < 3; ++i) { const u32x4 v = L[q][i]; const unsigned dw[4] = {v.x, v.y, v.z, v.w}; \
                    _Pragma("unroll") for (int k = 0; k < 4; ++k) { const f32x2c x2 = (f32x2c){lo_bf(dw[k]), hi_bf(dw[k])}; \
                        P[k] = __builtin_elementwise_fma(x2, w2[k][i * 3 + 2], P[k]); C[k] = __builtin_elementwise_fma(x2, w2[k][i * 3 + 1], C[k]); \
                        N[k] = __builtin_elementwise_fma(x2, w2[k][i * 3 + 0], i == 0 ? bias2[k] : N[k]); } } \
                const int oc = cc - 1; \
                if (oc >= start + ofirst && oc < start + 64) { \
                    f32x2c uu[4]; \
                    _Pragma("unroll") for (int k = 0; k < 4; ++k) { const f32x2c t = P[k] * -1.4426950408889634f; \
                        const f32x2c den = (f32x2c){__builtin_amdgcn_exp2f(t.x), __builtin_amdgcn_exp2f(t.y)} + 1.f; \
                        uu[k] = P[k] * (f32x2c){__builtin_amdgcn_rcpf(den.x), __builtin_amdgcn_rcpf(den.y)}; } \
                    if (cg < 2) { f32x2c s2 = uu[0] * uu[0]; s2 = __builtin_elementwise_fma(uu[1], uu[1], s2); s2 = __builtin_elementwise_fma(uu[2], uu[2], s2); s2 = __builtin_elementwise_fma(uu[3], uu[3], s2); \
                        float ss = s2.x + s2.y; ss += dppf<0xB1>(ss); ss += dppf<0x4E>(ss); ss += dppf<0x141>(ss); ss += dppf<0x140>(ss); \
                        const float sc = rsqrtf(ss + EPS) * (cg == 0 ? 0.08838834764831845f : 1.f); \
                        _Pragma("unroll") for (int k = 0; k < 4; ++k) uu[k] *= sc; } \
                    *(s16x8c*)(Fl + (size_t)(rb1 + oc) * FST) = cvt8c(uu[0].x, uu[0].y, uu[1].x, uu[1].y, uu[2].x, uu[2].y, uu[3].x, uu[3].y); } } while (0)
#define CONV_CHUNK(L, CH) do { const int c0_ = start - 1 + (CH) * 3; \
            if (!(v0 && v2 && c0_ >= lo && c0_ + 2 < hi)) {            \
                _Pragma("unroll") for (int q = 0; q < 3; ++q) { const int cc = c0_ + q; const bool cv = cc >= lo && cc < hi; const u32x4 z = (u32x4){0u, 0u, 0u, 0u}; \
                    L[q][0] = (cv && v0) ? L[q][0] : z; L[q][1] = cv ? L[q][1] : z; L[q][2] = (cv && v2) ? L[q][2] : z; } } \
            CONV_COL(L, CH, 0, a0, a1, a2); CONV_COL(L, CH, 1, a1, a2, a0); CONV_COL(L, CH, 2, a2, a0, a1); } while (0)
        u32x4 lA[3][3], lB[3][3];
        CONV_LOAD(lA, cbeg);
        for (int cp = 0; cp < npairs; ++cp) {
            CONV_LOAD(lB, cbeg + 2 * cp + 1); __builtin_amdgcn_sched_barrier(0);
            CONV_CHUNK(lA, cbeg + 2 * cp); __builtin_amdgcn_sched_barrier(0);
            if (cp + 1 < npairs) CONV_LOAD(lA, cbeg + 2 * cp + 2);
            __builtin_amdgcn_sched_barrier(0);
            CONV_CHUNK(lB, cbeg + 2 * cp + 1); __builtin_amdgcn_sched_barrier(0);
        }
#undef CONV_LOAD
#undef CONV_COL
#undef CONV_CHUNK
    }
}

__device__ __forceinline__ int scan_row(int b, int d, int s) {
    if (s < CTXL) { const int t = d ? CTXL - 1 - s : s; return NLAT + b * CTXL + t; }
    const int s2 = s - CTXL, t = d ? SEQ - 1 - s2 : s2; return b * SEQ + t;
}
__device__ __forceinline__ void phase_scan_naive(const Params& p, int l, unsigned char* smem, bool ctx_out, const int tid, const int bid) {
    const int lane = tid & 63, c32 = lane & 31, half = lane >> 5;
    const bf16_t* F = (const bf16_t*)(p.ws + WS_F); const float* SM = (const float*)(p.ws + WS_SM); bf16_t* OD = (bf16_t*)(p.ws + WS_OD);
    if (bid < 64) {
        float* sq = (float*)smem; float* sk = sq + 2 * 16 * 128; float* sv = sk + 2 * 16 * 128; float* sb = sv + 2 * 16 * 128; float* sg = sb + 32;
        const int cl = tid >> 8, t = tid & 255, j = (t >> 6) * 32 + c32, chain = bid * 2 + cl, b = chain >> 3, d = (chain >> 2) & 1, hd = chain & 3;
        const float Aexp = __expf(p.dn_A_log[(l * 2 + d) * 4 + hd]), dtb = p.dn_dt_bias[(l * 2 + d) * 4 + hd];
        float S[64];
#pragma unroll
        for (int n = 0; n < 64; ++n) S[n] = 0.f;
        bf16_t* od = OD + (size_t)d * NROW * 1024;
        for (int blk = 0; blk < 272; ++blk) {
            __syncthreads();
            for (int idx = t; idx < 2048; idx += 256) { const int i = idx >> 7, jq = idx & 127; const size_t R = (size_t)scan_row(b, d, blk * 16 + i); const bf16_t* fr = F + FADDR(R, hd * 128 + jq);
                sq[(cl * 16 + i) * 128 + jq] = bf2f(fr[0]); sk[(cl * 16 + i) * 128 + jq] = bf2f(fr[(size_t)4 * NROW * FST]); sv[(cl * 16 + i) * 128 + jq] = bf2f(fr[(size_t)8 * NROW * FST]); }
            if (t < 16) { const size_t R = (size_t)scan_row(b, d, blk * 16 + t);
                sb[cl * 16 + t] = sigmoid_f(SM[(size_t)(d * 4 + hd) * NROW + R]); sg[cl * 16 + t] = __expf(-Aexp * softplus_f(SM[(size_t)(8 + d * 4 + hd) * NROW + R] + dtb)); }
            __syncthreads();
            for (int i = 0; i < 16; ++i) {
                const float* kk = sk + (cl * 16 + i) * 128 + half * 64; const float* qq = sq + (cl * 16 + i) * 128 + half * 64;
                const float g = sg[cl * 16 + i], be = sb[cl * 16 + i], v = sv[(cl * 16 + i) * 128 + j];
                float kS = 0.f;
#pragma unroll
                for (int n0 = 0; n0 < 64; n0 += 16) {
#pragma unroll
                    for (int n = n0; n < n0 + 16; ++n) kS += kk[n] * S[n];
                    asm volatile("" ::: "memory"); }
                kS += lane_get(kS, lane ^ 32);
                const float cf = be * (v - g * kS);
                float o = 0.f;
#pragma unroll
                for (int n0 = 0; n0 < 64; n0 += 16) {
#pragma unroll
                    for (int n = n0; n < n0 + 16; ++n) { S[n] = g * S[n] + kk[n] * cf; o += qq[n] * S[n]; }
                    asm volatile("" ::: "memory"); }
                o += lane_get(o, lane ^ 32);
                const int s = blk * 16 + i;
                if (half == 0 && (s >= CTXL || ctx_out)) od[OADDR(scan_row(b, d, s), hd * 128 + j)] = f2bf(o);
            }
        }
    } else if (bid < 128) {
        float* sB = (float*)smem; float* sC = sB + 4 * 8 * 128; float* sx = sC + 4 * 8 * 128; float* sdt = sx + 4 * 8 * 64;
        const int cl = tid >> 7, t = tid & 127, pp = (t >> 6) * 32 + c32, chain = (bid - 64) * 4 + cl, b = chain >> 4, d = (chain >> 3) & 1, head = chain & 7, g = head >> 2;
        const float Aneg = -__expf(p.ssm_A_log[(l * 2 + d) * 8 + head]), dtb = p.ssm_dt_bias[(l * 2 + d) * 8 + head];
        float h[64];
#pragma unroll
        for (int n = 0; n < 64; ++n) h[n] = 0.f;
        bf16_t* od = OD + (size_t)d * NROW * 1024;
        for (int blk = 0; blk < 544; ++blk) {
            __syncthreads();
            for (int idx = t; idx < 1024; idx += 128) { const int i = idx >> 7, n = idx & 127; const size_t R = (size_t)scan_row(b, d, blk * 8 + i);
                sB[(cl * 8 + i) * 128 + n] = bf2f(F[FADDR(R, 2048 + g * 128 + n)]); sC[(cl * 8 + i) * 128 + n] = bf2f(F[FADDR(R, 2304 + g * 128 + n)]); }
            for (int idx = t; idx < 512; idx += 128) { const int i = idx >> 6, q = idx & 63; const size_t R = (size_t)scan_row(b, d, blk * 8 + i);
                sx[(cl * 8 + i) * 64 + q] = bf2f(F[FADDR(R, 1536 + head * 64 + q)]); }
            if (t < 8) { const size_t R = (size_t)scan_row(b, d, blk * 8 + t); sdt[cl * 8 + t] = softplus_f(SM[(size_t)(16 + d * 8 + head) * NROW + R] + dtb); }
            __syncthreads();
            for (int i = 0; i < 8; ++i) {
                const float* bb = sB + (cl * 8 + i) * 128 + half * 64; const float* cc = sC + (cl * 8 + i) * 128 + half * 64;
                const float dt = sdt[cl * 8 + i], dec = __expf(dt * Aneg), xd = sx[(cl * 8 + i) * 64 + pp] * dt;
                float y = 0.f;
#pragma unroll
                for (int n0 = 0; n0 < 64; n0 += 16) {
#pragma unroll
                    for (int n = n0; n < n0 + 16; ++n) { h[n] = dec * h[n] + bb[n] * xd; y += cc[n] * h[n]; }
                    asm volatile("" ::: "memory"); }
                y += lane_get(y, lane ^ 32);
                const int s = blk * 8 + i;
                if (half == 0 && (s >= CTXL || ctx_out)) od[OADDR(scan_row(b, d, s), 512 + head * 64 + pp)] = f2bf(y + (d == 0 ? p.ssm_D[l * 8 + head] * sx[(cl * 8 + i) * 64 + pp] : 0.f));
            }
        }
    }
}

typedef short s16x8 __attribute__((ext_vector_type(8)));
typedef __bf16 bf16x8_t __attribute__((ext_vector_type(8)));
typedef float f32x8_t __attribute__((ext_vector_type(8)));
typedef float f32x16 __attribute__((ext_vector_type(16)));
typedef __bf16 bf16x16_t __attribute__((ext_vector_type(16)));
typedef short s16x16 __attribute__((ext_vector_type(16)));
#define MFMA32(a, b, c) __builtin_amdgcn_mfma_f32_32x32x16_bf16((a), (b), (c), 0, 0, 0)
__device__ __forceinline__ s16x8 cvt8(float a0, float a1, float a2, float a3, float a4, float a5, float a6, float a7) {
    f32x8_t v = {a0, a1, a2, a3, a4, a5, a6, a7}; return __builtin_bit_cast(s16x8, __builtin_convertvector(v, bf16x8_t)); }
#define PACK_STEP(x, sp) cvt8((x)[8 * (sp) + 0], (x)[8 * (sp) + 1], (x)[8 * (sp) + 2], (x)[8 * (sp) + 3], (x)[8 * (sp) + 4], (x)[8 * (sp) + 5], (x)[8 * (sp) + 6], (x)[8 * (sp) + 7])
__device__ __forceinline__ f32x16 zero16() { f32x16 z;
#pragma unroll
    for (int i = 0; i < 16; ++i) z[i] = 0.f;
    return z; }
__device__ __forceinline__ size_t chunk_row0(int b, int cidx) { return cidx < 4 ? (size_t)NLAT + b * CTXL + cidx * 64 : (size_t)b * SEQ + (cidx - 4) * 64; }
constexpr int SCL_FLOATS = 320;
constexpr int N_DNITEMS = NB * 68 * 4 * 2, N_SSDITEMS = NB * 68 * 2;

__device__ __forceinline__ void prep_dn_item(const Params& p, int l, int item2, float* At, float* Gs, float* Bs) {
    const int item = item2 >> 1, dsel = item2 & 1;
    int lane = __builtin_amdgcn_mbcnt_hi(~0u, __builtin_amdgcn_mbcnt_lo(~0u, 0u)); asm volatile("" : "+v"(lane));
    const int hd = item & 3, bc = item >> 2, cidx = bc % 68, b = bc / 68, r = lane & 31, h = lane >> 5;
    const size_t R0 = chunk_row0(b, cidx);
    const bf16_t* F = (const bf16_t*)(p.ws + WS_F); const float* SM = (const float*)(p.ws + WS_SM);
    const bf16_t* Fk = F + FADDR(R0, 512 + hd * 128); const bf16_t* Fq = F + FADDR(R0, hd * 128);
    unsigned char* tq = p.ws + WS_TQ + (size_t)item * 2 * 16384;
    float* scl = (float*)(p.ws + WS_SCL) + (size_t)item * 2 * SCL_FLOATS;
    s16x8 kf[2][8];
    {   unsigned char* kimg = (unsigned char*)At; const unsigned char* ksrc = (const unsigned char*)Fk; u32x4 tmp[16];
#pragma unroll
        for (int i = 0; i < 16; ++i) tmp[i] = *(const u32x4*)(ksrc + i * 1024 + lane * 16);
#pragma unroll
        for (int i = 0; i < 16; ++i) { const int row = 4 * i + (lane >> 4), seg = lane & 15; *(u32x4*)(kimg + row * 256 + ((seg ^ (row & 15)) * 16)) = tmp[i]; }
        asm volatile("" ::: "memory");
#pragma unroll
        for (int mt = 0; mt < 2; ++mt)
#pragma unroll
            for (int s = 0; s < 8; ++s) { const int row = 32 * mt + r; kf[mt][s] = *(const s16x8*)(kimg + row * 256 + (((2 * s + h) ^ (row & 15)) * 16)); }
        asm volatile("s_waitcnt lgkmcnt(0)" ::: "memory");
    }
    { const int d = dsel;
        const int tok = d ? 63 - lane : lane;
        const float dnb = SM[(size_t)(d * 4 + hd) * NROW + R0 + tok], dna = SM[(size_t)(8 + d * 4 + hd) * NROW + R0 + tok];
        const float be = sigmoid_f(dnb), lg = -__expf(p.dn_A_log[(l * 2 + d) * 4 + hd]) * softplus_f(dna + p.dn_dt_bias[(l * 2 + d) * 4 + hd]);
        const float x = wave_incl_scan(lg, lane);
        const float Gl = lane_get(x, 63);
        Gs[d * 64 + tok] = x; Bs[d * 64 + tok] = be;
        float* sc = scl + d * SCL_FLOATS; const float eg = __expf(x);
        sc[tok] = be; sc[64 + tok] = be * eg; sc[128 + tok] = eg; sc[192 + tok] = __expf(Gl - x); if (lane == 0) sc[256] = __expf(Gl);
    }
    { const int d = dsel;
        asm volatile("" ::: "memory");
        {
#pragma unroll
            for (int bt = 0; bt < 2; ++bt) { const int x = 32 * bt + r; const float gx = Gs[d * 64 + x], bx = Bs[d * 64 + x]; const int ox = d ? 63 - x : x;
#pragma unroll
                for (int at = 0; at < 2; ++at) { f32x16 kk = zero16();
                    if (at == bt || (d ? at > bt : at < bt))
#pragma unroll
                    for (int s = 0; s < 8; ++s) kk = MFMA32(kf[at][s], kf[bt][s], kk);
#pragma unroll
                    for (int q4 = 0; q4 < 4; ++q4) { const int y0 = 32 * at + 8 * q4 + 4 * h; const f32x4 gy = *(const f32x4*)(Gs + d * 64 + y0);
#pragma unroll
                        for (int e = 0; e < 4; ++e) { const int y = y0 + e; const bool valid = d ? (y > x) : (y < x);
                            const float val = valid ? bx * kk[4 * q4 + e] * __expf(gx - gy[e]) : 0.f;
                            At[(d ? 63 - y : y) * 64 + ox] = val; } } } }
            asm volatile("" ::: "memory");
    #pragma unroll
            for (int it = 0; it < 2; ++it) { const int i = 32 * it + r; s16x8 qf[8];
    #pragma unroll
                for (int s = 0; s < 8; ++s) qf[s] = *(const s16x8*)(Fq + (size_t)i * FST + 16 * s + 8 * h);
    #pragma unroll
                for (int jt = 0; jt < 2; ++jt) { f32x16 x = zero16();
                    if (jt == it || (dsel ? jt > it : jt < it))
    #pragma unroll
                    for (int s = 0; s < 8; ++s) x = MFMA32(kf[jt][s], qf[s], x);
                    { const int d = dsel; const float gi = Gs[d * 64 + i]; float v[16];
    #pragma unroll
                        for (int q4 = 0; q4 < 4; ++q4) { const int j0 = 32 * jt + 8 * q4 + 4 * h; const f32x4 gj = *(const f32x4*)(Gs + d * 64 + j0);
    #pragma unroll
                            for (int e = 0; e < 4; ++e) { const int j = j0 + e; const bool valid = d ? (j >= i) : (j <= i); v[4 * q4 + e] = valid ? x[4 * q4 + e] * __expf(gi - gj[e]) : 0.f; } }
                        unsigned char* qkf = tq + (size_t)d * 16384 + 8192;
                        if (jt == it || (dsel ? jt > it : jt < it))
    #pragma unroll
                        for (int sp = 0; sp < 2; ++sp)
                            *(s16x8*)(qkf + (size_t)(((it * 4 + 2 * jt + sp) * 64) + lane) * 16) = cvt8(v[8 * sp], v[8 * sp + 1], v[8 * sp + 2], v[8 * sp + 3], v[8 * sp + 4], v[8 * sp + 5], v[8 * sp + 6], v[8 * sp + 7]); } } }

        }
        asm volatile("" ::: "memory");
#if PREP_OLD
        float Tt[64]; int Ac[64];
#pragma unroll
        for (int i = 0; i < 64; ++i) Ac[i] = __float_as_int(At[i * 64 + lane]);
        asm volatile("" ::: "memory");
        Tt[63] = (lane == 63) ? 1.f : 0.f;
#pragma unroll
        for (int i = 62; i >= PROBE_SUBST_LO; --i) { float acc = (lane == i) ? 1.f : 0.f;
#pragma unroll
            for (int j = i + 1; j < 64; ++j) acc -= __int_as_float(__builtin_amdgcn_readlane(Ac[i], j)) * Tt[j];
            Tt[i] = acc; }
#else
        float Tt[64];
        {   const int hL = lane >> 5, cL = lane & 31;
            float TB[32];
            {   int AcS[31];
#pragma unroll
                for (int i = 0; i < 31; ++i) AcS[i] = __float_as_int(At[(32 * hL + i) * 64 + lane]);
                asm volatile("" ::: "memory");
#pragma unroll
                for (int i = 0; i < 31; ++i) TB[i] = 0.f;
                TB[31] = (cL == 31) ? 1.f : 0.f;
#pragma unroll
                for (int pass = 0; pass < 2; ++pass) {
#pragma unroll
                    for (int i = 30; i >= 0; --i) { float acc = (cL == i) ? 1.f : 0.f;
#pragma unroll
                        for (int j = i + 1; j < 32; ++j) acc -= __int_as_float(__builtin_amdgcn_readlane(AcS[i], 32 * pass + j)) * TB[j];
                        TB[i] = (hL == pass) ? acc : TB[i]; }
                }
            }
            {   float* Q = At + (hL ? 32 * 64 + 32 : 0);
#pragma unroll
                for (int jj = 0; jj < 32; ++jj) Q[cL * 64 + (jj ^ cL)] = TB[jj]; }
            asm volatile("" ::: "memory");
            f32x16 P = zero16();
#pragma unroll
            for (int s2 = 0; s2 < 16; ++s2) { const int kk = 2 * s2 + hL; const float av = At[kk * 64 + 32 + cL], bv = At[kk * 64 + (cL ^ kk)]; P = __builtin_amdgcn_mfma_f32_32x32x2f32(av, bv, P, 0, 0, 0); }
            f32x16 Dm = zero16();
#pragma unroll
            for (int s2 = 0; s2 < 16; ++s2) { const int kk = (s2 & 3) + 8 * (s2 >> 2) + 4 * hL; const float av = At[(32 + cL) * 64 + 32 + (kk ^ cL)]; Dm = __builtin_amdgcn_mfma_f32_32x32x2f32(av, P[s2], Dm, 0, 0, 0); }
            asm volatile("" ::: "memory");
#pragma unroll
            for (int reg = 0; reg < 16; ++reg) { const int row = (reg & 3) + 8 * (reg >> 2) + 4 * hL; At[row * 64 + 32 + (cL ^ row)] = -Dm[reg]; }
            asm volatile("" ::: "memory");
#pragma unroll
            for (int jj = 0; jj < 32; ++jj) { const float t21 = At[cL * 64 + 32 + (jj ^ cL)];
                Tt[jj] = hL ? t21 : TB[jj]; Tt[32 + jj] = hL ? TB[jj] : 0.f; }
            asm volatile("" ::: "memory");
        }
#endif
        const int gam = d ? 63 - lane : lane; unsigned char* tf = tq + (size_t)d * 16384;
#pragma unroll
        for (int s = 0; s < 4; ++s)
#pragma unroll
            for (int hh = 0; hh < 2; ++hh) { float v[8];
#pragma unroll
                for (int jj = 0; jj < 8; ++jj) { const int rho = 16 * s + 8 * (jj >> 2) + 4 * hh + (jj & 3); v[jj] = d ? Tt[63 - rho] : Tt[rho]; }
                if (!(d ? ((gam >> 5) == 1 && s < 2) : ((gam >> 5) == 0 && s >= 2)))
                *(s16x8*)(tf + (size_t)((((gam >> 5) * 4 + s) * 64) + (gam & 31) + 32 * hh) * 16) = cvt8(v[0], v[1], v[2], v[3], v[4], v[5], v[6], v[7]); }
    }
    asm volatile("" ::: "memory");
    asm volatile("" ::: "memory");
}
__device__ __forceinline__ void prep_ssd_item(const Params& p, int item) {
    int lane = __builtin_amdgcn_mbcnt_hi(~0u, __builtin_amdgcn_mbcnt_lo(~0u, 0u)); asm volatile("" : "+v"(lane));
    const int g = item & 1, bc = item >> 1, cidx = bc % 68, b = bc / 68, r = lane & 31, h = lane >> 5;
    const size_t R0 = chunk_row0(b, cidx);
    const bf16_t* F = (const bf16_t*)(p.ws + WS_F); const bf16_t* FB = F + FADDR(R0, 2048 + g * 128); const bf16_t* FC = F + FADDR(R0, 2304 + g * 128);
    unsigned char* cb = p.ws + WS_CB + (size_t)item * 8192;
    s16x8 bf[2][8], cf[2][8];
#pragma unroll
    for (int mt = 0; mt < 2; ++mt)
#pragma unroll
        for (int s = 0; s < 8; ++s) { bf[mt][s] = *(const s16x8*)(FB + (size_t)(32 * mt + r) * FST + 16 * s + 8 * h); cf[mt][s] = *(const s16x8*)(FC + (size_t)(32 * mt + r) * FST + 16 * s + 8 * h); }
#pragma unroll
    for (int jt = 0; jt < 2; ++jt)
#pragma unroll
        for (int it = 0; it < 2; ++it) { f32x16 acc = zero16();
#pragma unroll
            for (int s = 0; s < 8; ++s) acc = MFMA32(bf[jt][s], cf[it][s], acc);
#pragma unroll
            for (int sp = 0; sp < 2; ++sp) *(s16x8*)(cb + (size_t)(((it * 4 + 2 * jt + sp) * 64) + lane) * 16) = PACK_STEP(acc, sp); }
}
__device__ __forceinline__ void phase_prep(const Params& p, int l, unsigned char* smem, const int tid, const int bid, const int nblk) {
    const int wid = __builtin_amdgcn_readfirstlane(tid >> 6), gw = bid * 8 + wid, NGW = nblk * 8;
    float* At = (float*)(smem + (size_t)wid * 17408); float* Gs = At + 4096; float* Bs = Gs + 128;
    if (nblk == 256) {
        for (int k = 0; k < 4; ++k) prep_dn_item(p, l, k * NGW + gw, At, Gs, Bs);
        if (wid < 2) prep_dn_item(p, l, 4 * NGW + wid * 256 + bid, At, Gs, Bs);
        prep_ssd_item(p, gw);
        if (wid == 4 && bid < N_SSDITEMS - 2048) prep_ssd_item(p, 2048 + bid);
    } else {
        for (int it = gw; it < N_DNITEMS; it += NGW) prep_dn_item(p, l, it, At, Gs, Bs);
        for (int it = NGW - 1 - gw; it < N_SSDITEMS; it += NGW) prep_ssd_item(p, it);
    }
}

struct StagePerm { u32x4 c0[2], c1[2]; };
__device__ __forceinline__ void stage_perm_load(StagePerm& t, const bf16_t* src, int hw, int lane) {
#pragma unroll
    for (int ps = 0; ps < 2; ++ps) { const int row = 16 * hw + 8 * ps + (lane >> 3), s = lane & 7; const bf16_t* q = src + (size_t)row * FST + 16 * s;
        t.c0[ps] = *(const u32x4*)q; t.c1[ps] = *(const u32x4*)(q + 8); }
}
__device__ __forceinline__ void stage_perm_store(const StagePerm& t, unsigned char* dst, int hw, int lane) {
#pragma unroll
    for (int ps = 0; ps < 2; ++ps) { const int row = 16 * hw + 8 * ps + (lane >> 3), s = lane & 7, mt = row >> 5, rr = row & 31;
        *(u32x4*)(dst + ((mt * 8 + s) * 64 + rr) * 16) = (u32x4){t.c0[ps].x, t.c0[ps].y, t.c1[ps].x, t.c1[ps].y};
        *(u32x4*)(dst + ((mt * 8 + s) * 64 + rr + 32) * 16) = (u32x4){t.c0[ps].z, t.c0[ps].w, t.c1[ps].z, t.c1[ps].w}; }
}
struct StageT { unsigned short v[4][8]; };
__device__ __forceinline__ void stage_t_load(StageT& t, const bf16_t* src, int hw, int lane) {
    const int r = lane & 31, h = lane >> 5;
#pragma unroll
    for (int s = 0; s < 4; ++s)
#pragma unroll
        for (int jj = 0; jj < 8; ++jj) t.v[s][jj] = src[(size_t)(16 * s + 8 * (jj >> 2) + 4 * h + (jj & 3)) * FST + 32 * hw + r];
}
__device__ __forceinline__ void stage_t_store(const StageT& t, unsigned char* dst, int hw, int lane) {
#pragma unroll
    for (int s = 0; s < 4; ++s) { u32x4 w; w.x = (unsigned)t.v[s][0] | ((unsigned)t.v[s][1] << 16); w.y = (unsigned)t.v[s][2] | ((unsigned)t.v[s][3] << 16);
        w.z = (unsigned)t.v[s][4] | ((unsigned)t.v[s][5] << 16); w.w = (unsigned)t.v[s][6] | ((unsigned)t.v[s][7] << 16);
        *(u32x4*)(dst + ((hw * 4 + s) * 64 + lane) * 16) = w; }
}
__device__ __forceinline__ void gather_cols(s16x8 (&f)[4], const bf16_t* src_col, int h) {
#pragma unroll
    for (int s = 0; s < 4; ++s)
#pragma unroll
        for (int jj = 0; jj < 8; ++jj) f[s][jj] = (short)src_col[(size_t)(16 * s + 8 * (jj >> 2) + 4 * h + (jj & 3)) * FST];
}
__device__ __forceinline__ void rows_load(u32x4 (&v)[4], const bf16_t* src_row0, int lane) {
#pragma unroll
    for (int q = 0; q < 4; ++q) v[q] = *(const u32x4*)(src_row0 + (size_t)(16 * q + (lane >> 2)) * FST + 8 * (lane & 3));
}
__device__ __forceinline__ void rows_park(const u32x4 (&v)[4], unsigned char* img, int lane) {
#pragma unroll
    for (int q = 0; q < 4; ++q) *(u32x4*)(img + (16 * q + (lane >> 2)) * 80 + 16 * (lane & 3)) = v[q];
}
__device__ __forceinline__ void frags_from_img(s16x8 (&f)[4], const unsigned char* img, int r, int h) {
#pragma unroll
    for (int s = 0; s < 4; ++s)
#pragma unroll
        for (int jj = 0; jj < 8; ++jj) f[s][jj] = (short)*(const unsigned short*)(img + (16 * s + 8 * (jj >> 2) + 4 * h + (jj & 3)) * 80 + 2 * r);
}
__device__ __forceinline__ int scan_chunk(int d, int step) { return d == 0 ? step : (step < 4 ? 3 - step : 71 - step); }

constexpr int DNB_QA = 16384, DNB_KT = 32768, DNB_T = 49152, DNB_QK = 57344, DNB_SC = 65536, DNB_BYTES = 66816 + 256, DN_IMG = 2 * DNB_BYTES, IMG_BYTES = 5120;
struct Band { u32x4 c[4]; };
__device__ __forceinline__ void band_load(Band& t, const bf16_t* src, int hw, int lane) {
#pragma unroll
    for (int i = 0; i < 4; ++i) t.c[i] = *(const u32x4*)(src + (size_t)(16 * i + (lane >> 2)) * FST + 32 * hw + 8 * (lane & 3));
}
__device__ __forceinline__ void band_store_perm(const Band& t, unsigned char* dst, int hw, int lane) {
    const int seg = lane & 3, s = 2 * hw + (seg >> 1); typedef unsigned u32x2_t __attribute__((ext_vector_type(2)));
#pragma unroll
    for (int i = 0; i < 4; ++i) { const int mt = i >> 1, rr = 16 * (i & 1) + (lane >> 2);
        *(u32x2_t*)(dst + ((mt * 8 + s) * 64 + rr) * 16 + 8 * (seg & 1)) = (u32x2_t){t.c[i].x, t.c[i].y};
        *(u32x2_t*)(dst + ((mt * 8 + s) * 64 + rr + 32) * 16 + 8 * (seg & 1)) = (u32x2_t){t.c[i].z, t.c[i].w}; }
}
__device__ __forceinline__ void band_store_transposed(const unsigned char* perm, unsigned char* dst, int hw, int lane) {
    const int r = lane & 31, h = lane >> 5;
    const unsigned char* base = perm + (size_t)((2 * hw + (r >> 4)) * 64 + 32 * ((r >> 2) & 1)) * 16 + 2 * (4 * ((r >> 3) & 1) + (r & 3));
#pragma unroll
    for (int s2 = 0; s2 < 4; ++s2) { unsigned short v[8];
#pragma unroll
        for (int jj = 0; jj < 8; ++jj) { const int tok = 16 * s2 + 8 * (jj >> 2) + 4 * h + (jj & 3);
            v[jj] = *(const unsigned short*)(base + (size_t)(((s2 >> 1) * 8) * 64 + (tok & 31)) * 16); }
        u32x4 w; w.x = (unsigned)v[0] | ((unsigned)v[1] << 16); w.y = (unsigned)v[2] | ((unsigned)v[3] << 16); w.z = (unsigned)v[4] | ((unsigned)v[5] << 16); w.w = (unsigned)v[6] | ((unsigned)v[7] << 16);
        *(u32x4*)(dst + ((hw * 4 + s2) * 64 + lane) * 16) = w; }
}
struct DnStage { Band bk, bq; u32x4 cp[5]; };
__device__ __forceinline__ void dn_stage_load(DnStage& g, const Params& p, int b, int d, int hd, int cidx, int hw, int lane) {
    asm volatile("" : "+s"(hw));
    const bf16_t* F = (const bf16_t*)(p.ws + WS_F); const size_t R0 = chunk_row0(b, cidx);
    const bf16_t* Fq = F + FADDR(R0, hd * 128); const bf16_t* Fk = F + FADDR(R0, 512 + hd * 128);
    const size_t item = ((size_t)(b * 68 + cidx) * 4 + hd);
    const unsigned char* tq = p.ws + WS_TQ + (item * 2 + d) * 16384; const unsigned char* sc = (const unsigned char*)((const float*)(p.ws + WS_SCL) + (item * 2 + d) * SCL_FLOATS);
    band_load(g.bk, Fk, hw, lane); band_load(g.bq, Fq, hw, lane);
    const int t256 = hw * 64 + lane;
#pragma unroll
    for (int i = 0; i < 4; ++i) {
        const bool zf = d ? ((i & 1) == 1 && hw < 2) : ((i & 1) == 0 && hw >= 2);
        g.cp[i] = zf ? (u32x4){0u, 0u, 0u, 0u} : *(const u32x4*)(tq + (size_t)(i * 256 + t256) * 16); }
    g.cp[4] = *(const u32x4*)(sc + (t256 < 80 ? t256 : 0) * 16);
}
__device__ __forceinline__ void dn_stage_store(const DnStage& g, unsigned char* buf, int hw, int lane) {
    asm volatile("" : "+s"(hw));
    const int t256 = hw * 64 + lane;
    band_store_perm(g.bk, buf, hw, lane); band_store_perm(g.bq, buf + DNB_QA, hw, lane); band_store_transposed(buf, buf + DNB_KT, hw, lane);
#pragma unroll
    for (int i = 0; i < 4; ++i) *(u32x4*)(buf + DNB_T + (i * 256 + t256) * 16) = g.cp[i];
    if (t256 < 80) *(u32x4*)(buf + DNB_SC + t256 * 16) = g.cp[4];
}
__device__ __forceinline__ void dn_scan_chain(const Params& p, int chain, unsigned char* smem, bool ctx_out, int wid) {
    const int b = chain >> 3, d = (chain >> 2) & 1, hd = chain & 3;
    int lane = __builtin_amdgcn_mbcnt_hi(~0u, __builtin_amdgcn_mbcnt_lo(~0u, 0u)); asm volatile("" : "+v"(lane)); int r = lane & 31, h = lane >> 5;
    const bf16_t* F = (const bf16_t*)(p.ws + WS_F); bf16_t* od = (bf16_t*)(p.ws + WS_OD) + (size_t)d * NROW * 1024;
    if (wid >= 4) {
        DnStage g;
        dn_stage_load(g, p, b, d, hd, scan_chunk(d, 0), wid - 4, lane); dn_stage_store(g, smem, wid - 4, lane);
        dn_stage_load(g, p, b, d, hd, scan_chunk(d, 1), wid - 4, lane);
        __syncthreads();
        for (int step = 0; step < 68; ++step) {
            lane = __builtin_amdgcn_mbcnt_hi(~0u, __builtin_amdgcn_mbcnt_lo(~0u, 0u)); asm volatile("" : "+v"(lane));
            if (step + 1 < 68) dn_stage_store(g, smem + ((step + 1) & 1) * DNB_BYTES, wid - 4, lane);
            if (step + 2 < 68) dn_stage_load(g, p, b, d, hd, scan_chunk(d, step + 2), wid - 4, lane);
            __syncthreads();
        }
        return;
    }
    __builtin_amdgcn_s_setprio(2);
    f32x16 S[4];
#pragma unroll
    for (int i = 0; i < 4; ++i) S[i] = zero16();
    u32x4 vrow[4];
    const int vcol0 = 1024 + hd * 128 + 32 * (wid & 3);
    unsigned char* img = smem + DN_IMG + (wid & 3) * IMG_BYTES;
    if (wid < 4) rows_load(vrow, F + FADDR(chunk_row0(b, scan_chunk(d, 0)), vcol0), lane);
    bool pwr = false; size_t pR0 = 0;
    __syncthreads();
    for (int step = 0; step < 68; ++step) {
        lane = __builtin_amdgcn_mbcnt_hi(~0u, __builtin_amdgcn_mbcnt_lo(~0u, 0u)); asm volatile("" : "+v"(lane)); r = lane & 31; h = lane >> 5;
        unsigned char* buf = smem + (step & 1) * DNB_BYTES;
        {
            const int cidx = scan_chunk(d, step); const size_t R0 = chunk_row0(b, cidx);
            u32x4 orow[4];
#pragma unroll
            for (int q = 0; q < 4; ++q) orow[q] = *(const u32x4*)(img + (16 * q + (lane >> 2)) * 80 + 16 * (lane & 3));
            rows_park(vrow, img, lane);
            if (step > 0 && pwr) { bf16_t* op = od + OADDR(pR0 + (lane >> 2), hd * 128 + 32 * (wid & 3) + 8 * (lane & 3));
#pragma unroll
                for (int q = 0; q < 4; ++q) *(u32x4*)(op + (size_t)q * 8 * 2048) = orow[q]; }
            if (step + 1 < 68) rows_load(vrow, F + FADDR(chunk_row0(b, scan_chunk(d, step + 1)), vcol0), lane);
            const float* sc = (const float*)(buf + DNB_SC);
#define SCHED_FENCE() __builtin_amdgcn_sched_barrier(0)
            s16x8 Rb[4];
            {   f32x16 a0 = zero16(), a1 = zero16();
#pragma unroll
                for (int hf = 0; hf < 2; ++hf) { s16x8 fk[8];
#pragma unroll
                    for (int i = 0; i < 4; ++i) { fk[i] = *(const s16x8*)(buf + ((4 * hf + i) * 64 + lane) * 16); fk[4 + i] = *(const s16x8*)(buf + ((8 + 4 * hf + i) * 64 + lane) * 16); }
                    SCHED_FENCE();
#pragma unroll
                    for (int i = 0; i < 4; ++i) { const int s = 4 * hf + i; const s16x8 sb = PACK_STEP(S[s >> 1], s & 1); a0 = MFMA32(fk[i], sb, a0); a1 = MFMA32(fk[4 + i], sb, a1); }
                    SCHED_FENCE(); }
                s16x8 vf[4];
                frags_from_img(vf, img, r, h);
#pragma unroll
                for (int t = 0; t < 2; ++t)
#pragma unroll
                    for (int sp = 0; sp < 2; ++sp) { float v[8];
#pragma unroll
                        for (int q4 = 0; q4 < 2; ++q4) { const int i0 = 32 * t + 16 * sp + 8 * q4 + 4 * h; const f32x4 be = *(const f32x4*)(sc + i0), bg = *(const f32x4*)(sc + 64 + i0);
#pragma unroll
                            for (int e = 0; e < 4; ++e) v[4 * q4 + e] = be[e] * bf2f((unsigned short)vf[2 * t + sp][4 * q4 + e]) - bg[e] * (t == 0 ? a0[8 * sp + 4 * q4 + e] : a1[8 * sp + 4 * q4 + e]); }
                        Rb[2 * t + sp] = cvt8(v[0], v[1], v[2], v[3], v[4], v[5], v[6], v[7]); }
            }
            s16x8 Vb[4], Vw[4];
            {   s16x8 ft[8];
#pragma unroll
                for (int i = 0; i < 8; ++i) ft[i] = *(const s16x8*)(buf + DNB_T + (i * 64 + lane) * 16);
                SCHED_FENCE();
                f32x16 vn0 = zero16(), vn1 = zero16();
#pragma unroll
                for (int s = 0; s < 4; ++s) { vn0 = MFMA32(ft[s], Rb[s], vn0); vn1 = MFMA32(ft[4 + s], Rb[s], vn1); }
                SCHED_FENCE();
#pragma unroll
                for (int t = 0; t < 2; ++t)
#pragma unroll
                    for (int sp = 0; sp < 2; ++sp) { float v[8];
#pragma unroll
                        for (int q4 = 0; q4 < 2; ++q4) { const int i0 = 32 * t + 16 * sp + 8 * q4 + 4 * h; const f32x4 el = *(const f32x4*)(sc + 192 + i0);
#pragma unroll
                            for (int e = 0; e < 4; ++e) v[4 * q4 + e] = el[e] * (t == 0 ? vn0[8 * sp + 4 * q4 + e] : vn1[8 * sp + 4 * q4 + e]); }
                        Vb[2 * t + sp] = (t == 0) ? PACK_STEP(vn0, sp) : PACK_STEP(vn1, sp); Vw[2 * t + sp] = cvt8(v[0], v[1], v[2], v[3], v[4], v[5], v[6], v[7]); }
            }
            const bool wr = (cidx >= 4) || ctx_out;
            {   f32x16 o0 = zero16(), o1 = zero16();
#pragma unroll
                for (int hf = 0; hf < 2; ++hf) { s16x8 fq[8];
#pragma unroll
                    for (int i = 0; i < 4; ++i) { fq[i] = *(const s16x8*)(buf + DNB_QA + ((4 * hf + i) * 64 + lane) * 16); fq[4 + i] = *(const s16x8*)(buf + DNB_QA + ((8 + 4 * hf + i) * 64 + lane) * 16); }
                    SCHED_FENCE();
#pragma unroll
                    for (int i = 0; i < 4; ++i) { const int s = 4 * hf + i; const s16x8 sb = PACK_STEP(S[s >> 1], s & 1); o0 = MFMA32(fq[i], sb, o0); o1 = MFMA32(fq[4 + i], sb, o1); }
                    SCHED_FENCE(); }
                s16x8 fqk[8];
#pragma unroll
                for (int i = 0; i < 8; ++i) fqk[i] = *(const s16x8*)(buf + DNB_QK + (i * 64 + lane) * 16);
#pragma unroll
                for (int q4 = 0; q4 < 4; ++q4) { const f32x4 eg0 = *(const f32x4*)(sc + 128 + 8 * q4 + 4 * h), eg1 = *(const f32x4*)(sc + 128 + 32 + 8 * q4 + 4 * h);
#pragma unroll
                    for (int e = 0; e < 4; ++e) { o0[4 * q4 + e] *= eg0[e]; o1[4 * q4 + e] *= eg1[e]; } }
                SCHED_FENCE();
#pragma unroll
                for (int s = 0; s < 4; ++s) { o0 = MFMA32(fqk[s], Vb[s], o0); o1 = MFMA32(fqk[4 + s], Vb[s], o1); }
                SCHED_FENCE();
                {   const s16x16 ob0 = __builtin_bit_cast(s16x16, __builtin_convertvector(o0, bf16x16_t)), ob1 = __builtin_bit_cast(s16x16, __builtin_convertvector(o1, bf16x16_t));
#pragma unroll
                    for (int reg = 0; reg < 16; ++reg) { *(unsigned short*)(img + ((reg & 3) + 8 * (reg >> 2) + 4 * h) * 80 + 2 * r) = (unsigned short)ob0[reg];
                        *(unsigned short*)(img + (32 + (reg & 3) + 8 * (reg >> 2) + 4 * h) * 80 + 2 * r) = (unsigned short)ob1[reg]; } }
                pwr = wr; pR0 = R0;
            }
            {   s16x8 fkt[16];
#pragma unroll
                for (int i = 0; i < 16; ++i) fkt[i] = *(const s16x8*)(buf + DNB_KT + (i * 64 + lane) * 16);
                const float egl = sc[256];
#pragma unroll
                for (int st = 0; st < 4; ++st) S[st] = S[st] * egl;
                SCHED_FENCE();
#pragma unroll
                for (int s = 0; s < 4; ++s)
#pragma unroll
                    for (int st = 0; st < 4; ++st) S[st] = MFMA32(fkt[st * 4 + s], Vw[s], S[st]);
                SCHED_FENCE();
            }
#undef SCHED_FENCE
        }
        __syncthreads();
    }
    if (wid < 4 && pwr) { bf16_t* op = od + OADDR(pR0 + (lane >> 2), hd * 128 + 32 * (wid & 3) + 8 * (lane & 3));
#pragma unroll
        for (int q = 0; q < 4; ++q) *(u32x4*)(op + (size_t)q * 8 * 2048) = *(const u32x4*)(img + (16 * q + (lane >> 2)) * 80 + 16 * (lane & 3)); }
}

constexpr int SSB_BT = 16384, SSB_CB = 32768, SSB_SC = 40960, SSB_BYTES = 40960 + 2 * 1280, SS_IMG = 2 * SSB_BYTES, SS_SCR = SS_IMG + 4 * 5120;
struct SsdStage { Band bc, bb; u32x4 cp[2]; float dtv, Aneg; };
__device__ __forceinline__ void ssd_stage_load(SsdStage& q, const Params& p, int l, int b, int d, int g, int head0, int cidx, int hw, int lane) {
    asm volatile("" : "+s"(hw));
    const bf16_t* F = (const bf16_t*)(p.ws + WS_F); const float* SM = (const float*)(p.ws + WS_SM); const size_t R0 = chunk_row0(b, cidx);
    const bf16_t* FB = F + FADDR(R0, 2048 + g * 128); const bf16_t* FC = F + FADDR(R0, 2304 + g * 128);
    const unsigned char* cb = p.ws + WS_CB + ((size_t)(b * 68 + cidx) * 2 + g) * 8192;
    band_load(q.bc, FC, hw, lane); band_load(q.bb, FB, hw, lane);
    const int t256 = hw * 64 + lane;
#pragma unroll
    for (int i = 0; i < 2; ++i) {
        const bool zf = d ? (i == 1 && hw < 2) : (i == 0 && hw >= 2);
        q.cp[i] = zf ? (u32x4){0u, 0u, 0u, 0u} : *(const u32x4*)(cb + (size_t)(i * 256 + t256) * 16); }
    const int tok = d ? 63 - lane : lane;
    const int head = head0 + (hw & 1);
    q.Aneg = -__expf(p.ssm_A_log[(l * 2 + d) * 8 + head]); q.dtv = SM[(size_t)(16 + d * 8 + head) * NROW + R0 + tok] + p.ssm_dt_bias[(l * 2 + d) * 8 + head];
}
__device__ __forceinline__ void ssd_stage_store(const SsdStage& q, int d, unsigned char* buf, unsigned char* scr, int hw, int lane) {
    asm volatile("" : "+s"(hw));
    const int t256 = hw * 64 + lane;
    band_store_perm(q.bc, buf, hw, lane); band_store_perm(q.bb, scr, hw, lane); band_store_transposed(scr, buf + SSB_BT, hw, lane);
#pragma unroll
    for (int i = 0; i < 2; ++i) *(u32x4*)(buf + SSB_CB + (i * 256 + t256) * 16) = q.cp[i];
    if (hw < 2) {
        const int tok = d ? 63 - lane : lane; const float dtv = softplus_f(q.dtv);
        float x = dtv * q.Aneg;
        x = wave_incl_scan(x, lane);
        const float al = lane_get(x, 63);
        float* sc = (float*)(buf + SSB_SC) + hw * 320;
        sc[tok] = x * 1.4426950408889634f; sc[64 + tok] = dtv; sc[128 + tok] = dtv * __expf(al - x); sc[192 + tok] = __expf(x); if (lane == 0) sc[256] = __expf(al);
    }
}
template <int DIR> __device__ __forceinline__ void ssd_scan_block(const Params& p, int l, int idx, unsigned char* smem, bool ctx_out, int wid) {
    constexpr int d = DIR; const int b = idx >> 3, g = (idx >> 1) & 1, head0 = g * 4 + (idx & 1) * 2;
    int lane = __builtin_amdgcn_mbcnt_hi(~0u, __builtin_amdgcn_mbcnt_lo(~0u, 0u)); asm volatile("" : "+v"(lane)); int r = lane & 31, h = lane >> 5;
    const bf16_t* F = (const bf16_t*)(p.ws + WS_F); bf16_t* od = (bf16_t*)(p.ws + WS_OD) + (size_t)d * NROW * 1024;
    if (wid >= 4) {
        SsdStage q;
        ssd_stage_load(q, p, l, b, d, g, head0, scan_chunk(d, 0), wid - 4, lane); ssd_stage_store(q, d, smem, smem + SS_SCR, wid - 4, lane);
        ssd_stage_load(q, p, l, b, d, g, head0, scan_chunk(d, 1), wid - 4, lane);
        __syncthreads();
        for (int step = 0; step < 68; ++step) {
            lane = __builtin_amdgcn_mbcnt_hi(~0u, __builtin_amdgcn_mbcnt_lo(~0u, 0u)); asm volatile("" : "+v"(lane));
            if (step + 1 < 68) ssd_stage_store(q, d, smem + ((step + 1) & 1) * SSB_BYTES, smem + SS_SCR, wid - 4, lane);
            if (step + 2 < 68) ssd_stage_load(q, p, l, b, d, g, head0, scan_chunk(d, step + 2), wid - 4, lane);
            __syncthreads();
        }
        return;
    }
    const int hsel = (wid >> 1) & 1, head = head0 + hsel; int pcol = head * 64 + 32 * (wid & 1) + r;
    __builtin_amdgcn_s_setprio(2);
    f32x16 H[4];
#pragma unroll
    for (int i = 0; i < 4; ++i) H[i] = zero16();
    u32x4 xrow[4];
    const int xcol0 = 1536 + head * 64 + 32 * (wid & 1);
    unsigned char* img = smem + SS_IMG + (wid & 3) * IMG_BYTES;
    const float Dskip = p.ssm_D[l * 8 + head];
    if (wid < 4) rows_load(xrow, F + FADDR(chunk_row0(b, scan_chunk(d, 0)), xcol0), lane);
    bool pwr = false; size_t pR0 = 0;
    __syncthreads();
    for (int step = 0; step < 68; ++step) {
        lane = __builtin_amdgcn_mbcnt_hi(~0u, __builtin_amdgcn_mbcnt_lo(~0u, 0u)); asm volatile("" : "+v"(lane)); r = lane & 31; h = lane >> 5; pcol = head * 64 + 32 * (wid & 1) + r;
        unsigned char* buf = smem + (step & 1) * SSB_BYTES;
        {
            const int cidx = scan_chunk(d, step); const size_t R0 = chunk_row0(b, cidx);
            u32x4 orow[4];
#pragma unroll
            for (int q = 0; q < 4; ++q) orow[q] = *(const u32x4*)(img + (16 * q + (lane >> 2)) * 80 + 16 * (lane & 3));
            rows_park(xrow, img, lane);
            if (step > 0 && pwr) { bf16_t* op = od + OADDR(pR0 + (lane >> 2), 512 + head * 64 + 32 * (wid & 1) + 8 * (lane & 3));
#pragma unroll
                for (int q = 0; q < 4; ++q) *(u32x4*)(op + (size_t)q * 8 * 2048) = orow[q]; }
            if (step + 1 < 68) rows_load(xrow, F + FADDR(chunk_row0(b, scan_chunk(d, step + 1)), xcol0), lane);
            s16x8 xf[4];
            frags_from_img(xf, img, r, h);
            const float* sc = (const float*)(buf + SSB_SC) + hsel * 320;
            const bool wr = (cidx >= 4) || ctx_out;
            if (wr) {
                s16x8 xd[4];
#pragma unroll
                for (int s = 0; s < 4; ++s) { float v1[8];
#pragma unroll
                    for (int q4 = 0; q4 < 2; ++q4) { const f32x4 dt4 = *(const f32x4*)(sc + 64 + 16 * s + 8 * q4 + 4 * h);
#pragma unroll
                        for (int e = 0; e < 4; ++e) v1[4 * q4 + e] = bf2f((unsigned short)xf[s][4 * q4 + e]) * dt4[e]; }
                    xd[s] = cvt8(v1[0], v1[1], v1[2], v1[3], v1[4], v1[5], v1[6], v1[7]); }
                const int rr = r - 4 * h;
#pragma unroll
                for (int t = 0; t < 2; ++t) {
                    f32x16 y = zero16();
#pragma unroll
                    for (int s = 0; s < 8; ++s) y = MFMA32(*(const s16x8*)(buf + ((t * 8 + s) * 64 + lane) * 16), PACK_STEP(H[s >> 1], s & 1), y);
#pragma unroll
                    for (int q4 = 0; q4 < 4; ++q4) { const f32x4 ea = *(const f32x4*)(sc + 192 + 32 * t + 8 * q4 + 4 * h);
#pragma unroll
                        for (int e = 0; e < 4; ++e) y[4 * q4 + e] *= ea[e]; }
                    const float ai = sc[32 * t + r];
#pragma unroll
                    for (int s = 0; s < 4; ++s) {
                        const bool diag = (s >> 1) == t, full = d ? ((s >> 1) > t) : ((s >> 1) < t);
                        if (diag || full) {
                            const s16x8 raw = *(const s16x8*)(buf + SSB_CB + ((t * 4 + s) * 64 + lane) * 16); float v[8];
#pragma unroll
                            for (int q4 = 0; q4 < 2; ++q4) { const f32x4 aj = *(const f32x4*)(sc + 16 * s + 8 * q4 + 4 * h);
#pragma unroll
                                for (int e = 0; e < 4; ++e) { const int cj = 16 * (s & 1) + 8 * q4 + e; const float val = bf2f((unsigned short)raw[4 * q4 + e]) * __builtin_amdgcn_exp2f(ai - aj[e]);
                                    v[4 * q4 + e] = diag ? ((d ? (cj >= rr) : (cj <= rr)) ? val : 0.f) : val; } }
                            y = MFMA32(cvt8(v[0], v[1], v[2], v[3], v[4], v[5], v[6], v[7]), xd[s], y); } }
                    if (DIR == 0) {
#pragma unroll
                        for (int reg = 0; reg < 16; ++reg) y[reg] += Dskip * bf2f((unsigned short)xf[2 * t + (reg >> 3)][reg & 7]); }
                    { const s16x16 yb = __builtin_bit_cast(s16x16, __builtin_convertvector(y, bf16x16_t));
#pragma unroll
                    for (int reg = 0; reg < 16; ++reg) *(unsigned short*)(img + (32 * t + (reg & 3) + 8 * (reg >> 2) + 4 * h) * 80 + 2 * r) = (unsigned short)yb[reg]; }
                    asm volatile("" ::: "memory"); }
                asm volatile("" ::: "memory"); }
            pwr = wr; pR0 = R0;
            s16x8 xw[4];
#pragma unroll
            for (int s = 0; s < 4; ++s) { float v2[8];
#pragma unroll
                for (int q4 = 0; q4 < 2; ++q4) { const int j0 = 16 * s + 8 * q4 + 4 * h; const f32x4 w4 = *(const f32x4*)(sc + 128 + j0);
#pragma unroll
                    for (int e = 0; e < 4; ++e) v2[4 * q4 + e] = bf2f((unsigned short)xf[s][4 * q4 + e]) * w4[e]; }
                xw[s] = cvt8(v2[0], v2[1], v2[2], v2[3], v2[4], v2[5], v2[6], v2[7]); }
            const float eal = sc[256];
#pragma unroll
            for (int nt = 0; nt < 4; ++nt) { f32x16 a = H[nt] * eal;
#pragma unroll
                for (int s = 0; s < 4; ++s) a = MFMA32(*(const s16x8*)(buf + SSB_BT + ((nt * 4 + s) * 64 + lane) * 16), xw[s], a);
                H[nt] = a; }
        }
        __syncthreads();
    }
    if (wid < 4 && pwr) { bf16_t* op = od + OADDR(pR0 + (lane >> 2), 512 + head * 64 + 32 * (wid & 1) + 8 * (lane & 3));
#pragma unroll
        for (int q = 0; q < 4; ++q) *(u32x4*)(op + (size_t)q * 8 * 2048) = *(const u32x4*)(img + (16 * q + (lane >> 2)) * 80 + 16 * (lane & 3)); }
}
__device__ __forceinline__ void phase_scan_mfma(const Params& p, int l, unsigned char* smem, bool ctx_out, const int tid, const int bid, const int nblk) {
    const int wid = __builtin_amdgcn_readfirstlane(tid >> 6);
    for (int it = bid; it < 256; it += nblk) {
        if (it < 128) { if (PROBE_DN) dn_scan_chain(p, it, smem, ctx_out, wid); }
        else { const int idx = it - 128; if ((idx >> 2) & 1) ssd_scan_block<1>(p, l, idx, smem, ctx_out, wid); else ssd_scan_block<0>(p, l, idx, smem, ctx_out, wid); }
        __builtin_amdgcn_s_setprio(0);
        __syncthreads();
    }
}

__device__ __forceinline__ void phase_merge(const Params& p, int l, int nrows, const int tid, const int bid, const int nblk) {
    const int lane = tid & 63, gw = bid * 8 + (tid >> 6), NGW = nblk * 8;
    const bf16_t* F = (const bf16_t*)(p.ws + WS_F); const bf16_t* PR = (const bf16_t*)(p.ws + WS_PR); const bf16_t* OD0 = (const bf16_t*)(p.ws + WS_OD); const bf16_t* OD1 = OD0 + (size_t)NROW * 1024;
    bf16_t* MIX = (bf16_t*)(p.ws + WS_MIX);
    const int cd = lane * 8;
    float gdn[8], gss[8];
#pragma unroll
    for (int i = 0; i < 8; ++i) { gdn[i] = p.dn_norm_g[l * 128 + (cd & 127) + i]; gss[i] = p.ssm_norm_g[l * 512 + cd + i]; }
    for (int R0 = 2 * gw; R0 < nrows; R0 += 2 * NGW) {
        u32x4 la0[2], la1[2], lz0[2], ly0[2], ly1[2], lz1[2];
#pragma unroll
        for (int k = 0; k < 2; ++k) { const size_t ro = (size_t)(R0 + k) * 1024;
            la0[k] = *(const u32x4*)(OD0 + OADDR(R0 + k, cd)); la1[k] = *(const u32x4*)(OD1 + OADDR(R0 + k, cd)); lz0[k] = *(const u32x4*)(PR + ro + cd);
            ly0[k] = *(const u32x4*)(OD0 + OADDR(R0 + k, 512 + cd)); ly1[k] = *(const u32x4*)(OD1 + OADDR(R0 + k, 512 + cd)); lz1[k] = *(const u32x4*)(PR + ro + 512 + cd); }
#pragma unroll
        for (int k = 0; k < 2; ++k) {
        const size_t ro = (size_t)(R0 + k) * 1024;
        const u32x4 a0 = la0[k], a1 = la1[k], z0 = lz0[k], y0 = ly0[k], y1 = ly1[k], z1 = lz1[k];
        float o[8], yz[8];
        { const unsigned aa[4] = {a0.x, a0.y, a0.z, a0.w}, bb[4] = {a1.x, a1.y, a1.z, a1.w};
#pragma unroll
            for (int i = 0; i < 4; ++i) { o[2 * i] = lo_bf(aa[i]) + lo_bf(bb[i]); o[2 * i + 1] = hi_bf(aa[i]) + hi_bf(bb[i]); } }
        { const unsigned aa[4] = {y0.x, y0.y, y0.z, y0.w}, bb[4] = {y1.x, y1.y, y1.z, y1.w}, zz[4] = {z1.x, z1.y, z1.z, z1.w};
#pragma unroll
            for (int i = 0; i < 4; ++i) { yz[2 * i] = (lo_bf(aa[i]) + lo_bf(bb[i])) * silu_f(lo_bf(zz[i])); yz[2 * i + 1] = (hi_bf(aa[i]) + hi_bf(bb[i])) * silu_f(hi_bf(zz[i])); } }
        float s1 = 0.f, s2 = 0.f;
#pragma unroll
        for (int i = 0; i < 8; ++i) { s1 += o[i] * o[i]; s2 += yz[i] * yz[i]; }
        s1 += dppf<0xB1>(s1); s1 += dppf<0x4E>(s1); s1 += dppf<0x141>(s1); s1 += dppf<0x140>(s1);
        s2 += dppf<0xB1>(s2); s2 += dppf<0x4E>(s2); s2 += dppf<0x141>(s2); s2 += dppf<0x140>(s2); s2 += sxor<16>(s2);
        const float r1 = rsqrtf(s1 * (1.f / 128.f) + EPS), r2 = rsqrtf(s2 * (1.f / 256.f) + EPS);
        const unsigned zz[4] = {z0.x, z0.y, z0.z, z0.w};
        float dn[8], ss[8];
#pragma unroll
        for (int i = 0; i < 4; ++i) { dn[2 * i] = o[2 * i] * r1 * gdn[2 * i] * silu_f(lo_bf(zz[i])); dn[2 * i + 1] = o[2 * i + 1] * r1 * gdn[2 * i + 1] * silu_f(hi_bf(zz[i])); }
#pragma unroll
        for (int i = 0; i < 8; ++i) ss[i] = yz[i] * r2 * gss[i];
        u32x4 w0, w1; w0.x = pk2(dn[0], dn[1]); w0.y = pk2(dn[2], dn[3]); w0.z = pk2(dn[4], dn[5]); w0.w = pk2(dn[6], dn[7]);
        w1.x = pk2(ss[0], ss[1]); w1.y = pk2(ss[2], ss[3]); w1.z = pk2(ss[4], ss[5]); w1.w = pk2(ss[6], ss[7]);
        *(u32x4*)(MIX + ro + cd) = w0; *(u32x4*)(MIX + ro + 512 + cd) = w1;
        }
    }
}

__device__ __forceinline__ void phase_resid1(const Params& p, int l, unsigned char* smem, int nrows, const int tid, const int bid, const int nblk) {
    float* rw = (float*)smem;
    const int lane = tid & 63, gw = bid * 8 + (tid >> 6), NGW = nblk * 8;
    {   f32x4 rv[8];
#pragma unroll
        for (int it = 0; it < 8; ++it) rv[it] = *(const f32x4*)(p.router_w + (size_t)l * 16384 + 4 * (tid + 512 * it));
#pragma unroll
        for (int it = 0; it < 8; ++it) { const int i4 = tid + 512 * it, k = i4 >> 2, c = i4 & 3; rw[(4 * c + 0) * 1024 + k] = rv[it].x; rw[(4 * c + 1) * 1024 + k] = rv[it].y; rw[(4 * c + 2) * 1024 + k] = rv[it].z; rw[(4 * c + 3) * 1024 + k] = rv[it].w; } }
    __syncthreads();
    const bf16_t* M = (const bf16_t*)(p.ws + WS_M); const float* mod = (const float*)(p.ws + WS_MOD);
    float* aff = (float*)(p.ws + WS_AFF); float* affb = (float*)(smem + 65536 + (size_t)(tid >> 6) * 4096);
    const float* g1 = p.norm_g + (l * 4 + 1) * D; const float* g2 = p.norm_g + (l * 4 + 2) * D;
    const int rpw = (nrows / 2 + NGW - 1) / NGW * 2, rbeg = gw * rpw, rend = (rbeg + rpw < nrows) ? rbeg + rpw : nrows;
    f32x4 cg1[4], cg2[4], cgt[4], csh[4], csc[4]; int cur_r = -1;
#pragma unroll
    for (int j = 0; j < 4; ++j) { cg1[j] = *(const f32x4*)(g1 + 256 * j + 4 * lane); cg2[j] = *(const f32x4*)(g2 + 256 * j + 4 * lane); }
    for (int R0 = rbeg; R0 < rend; R0 += 2) {
        u32x2 lm[2][4]; f32x4 lx[2][4];
#pragma unroll
        for (int k = 0; k < 2; ++k) {
#pragma unroll
            for (int j = 0; j < 4; ++j) { const int i = 256 * j + 4 * lane; lm[k][j] = *(const u32x2*)(M + (size_t)(R0 + k) * D + i); }
            if (l == 0) { const float* xr = xres_in(p, 0, R0 + k);
#pragma unroll
                for (int j = 0; j < 4; ++j) lx[k][j] = *(const f32x4*)(xr + 256 * j + 4 * lane); }
            else { const bf16_t* xr = xb_ptr(p, R0 + k);
#pragma unroll
                for (int j = 0; j < 4; ++j) lx[k][j] = unpack4(*(const u32x2*)(xr + 256 * j + 4 * lane)); } }
#pragma unroll
        for (int k = 0; k < 2; ++k) {
        const int R = R0 + k; bf16_t* xo = (l == DEPTH - 1) ? xl_ptr(p, R) : xb_ptr(p, R);
        { const int mr = __builtin_amdgcn_readfirstlane(row_modr(R)); if (mr != cur_r) { cur_r = mr; const float* md = mod + (size_t)(l * 17 + mr) * NMOD;
#pragma unroll
                for (int j = 0; j < 4; ++j) { const int i = 256 * j + 4 * lane; cgt[j] = *(const f32x4*)(md + 2 * D + i); csh[j] = *(const f32x4*)(md + 3 * D + i); csc[j] = *(const f32x4*)(md + 4 * D + i); } } }
        f32x4 mv[4], xv[4]; float ss = 0.f;
#pragma unroll
        for (int j = 0; j < 4; ++j) { const u32x2 t = lm[k][j];
            mv[j] = (f32x4){lo_bf(t.x), hi_bf(t.x), lo_bf(t.y), hi_bf(t.y)}; xv[j] = lx[k][j];
            ss += mv[j].x * mv[j].x + mv[j].y * mv[j].y + mv[j].z * mv[j].z + mv[j].w * mv[j].w; }
        const float rstd = rsqrtf(wave_sum(ss, lane) * (1.f / D) + EPS);
        float ss2 = 0.f;
#pragma unroll
        for (int j = 0; j < 4; ++j) { const int i = 256 * j + 4 * lane;
            xv[j] = xv[j] + cgt[j] * (mv[j] * rstd * cg1[j]); { u32x2 o; o.x = pk2(xv[j].x, xv[j].y); o.y = pk2(xv[j].z, xv[j].w); *(u32x2*)(xo + i) = o; xv[j] = unpack4(o); }
            ss2 += xv[j].x * xv[j].x + xv[j].y * xv[j].y + xv[j].z * xv[j].z + xv[j].w * xv[j].w; }
        const float rstd2 = rsqrtf(wave_sum(ss2, lane) * (1.f / D) + EPS);
        f32x4 hv[4];
#pragma unroll
        for (int j = 0; j < 4; ++j) hv[j] = xv[j] * rstd2 * cg2[j] * (csc[j] + 1.f) + csh[j];
        { bf16_t* h2row = (bf16_t*)(p.ws + WS_H2) + (size_t)R * D;
#pragma unroll
            for (int j = 0; j < 4; ++j) { u32x2 o; o.x = pk2(hv[j].x, hv[j].y); o.y = pk2(hv[j].z, hv[j].w); *(u32x2*)(h2row + 256 * j + 4 * lane) = o; } }
        float ps[16];
#pragma unroll
        for (int e = 0; e < 16; ++e) { float sacc = 0.f;
#pragma unroll
            for (int j = 0; j < 4; ++j) { const f32x4 wv = *(const f32x4*)(rw + e * 1024 + 256 * j + 4 * lane); sacc += hv[j].x * wv.x + hv[j].y * wv.y + hv[j].z * wv.z + hv[j].w * wv.w; }
            ps[e] = sacc; if ((e & 3) == 3) asm volatile("" ::: "memory"); }
        const bool b5 = (lane & 32) != 0, b4 = (lane & 16) != 0, b3 = (lane & 8) != 0, b2 = (lane & 4) != 0;
        float v8[8], v4[4], v2[2], lg1;
#pragma unroll
        for (int i = 0; i < 8; ++i) { const float snd = b5 ? ps[i] : ps[8 + i]; const float kp = b5 ? ps[8 + i] : ps[i]; v8[i] = kp + lane_get(snd, lane ^ 32); }
#pragma unroll
        for (int i = 0; i < 4; ++i) { const float snd = b4 ? v8[i] : v8[4 + i]; const float kp = b4 ? v8[4 + i] : v8[i]; v4[i] = kp + sxor<16>(snd); }
#pragma unroll
        for (int i = 0; i < 2; ++i) { const float snd = b3 ? v4[i] : v4[2 + i]; const float kp = b3 ? v4[2 + i] : v4[i]; v2[i] = kp + sxor<8>(snd); }
        { const float snd = b2 ? v2[0] : v2[1]; const float kp = b2 ? v2[1] : v2[0]; lg1 = kp + sxor<4>(snd); }
        lg1 += sxor<2>(lg1); lg1 += sxor<1>(lg1);
        float mx = lg1;
        mx = fmaxf(mx, sxor<4>(mx)); mx = fmaxf(mx, sxor<8>(mx)); mx = fmaxf(mx, sxor<16>(mx)); mx = fmaxf(mx, lane_get(mx, lane ^ 32));
        const float ex = __expf(lg1 - mx);
        float den = ex;
        den += sxor<4>(den); den += sxor<8>(den); den += sxor<16>(den); den += lane_get(den, lane ^ 32);
        if ((lane & 3) == 0) { const int e = ((lane >> 5) & 1) * 8 + ((lane >> 4) & 1) * 4 + ((lane >> 3) & 1) * 2 + ((lane >> 2) & 1);
            affb[e * 64 + (R - rbeg)] = ex * __builtin_amdgcn_rcpf(den); }
        }
    }
    asm volatile("s_waitcnt lgkmcnt(0)" ::: "memory");
    { const int nrw = rend > rbeg ? rend - rbeg : 0, nel = nrw * 16;
        for (int i2 = lane; i2 < nel; i2 += 64) { const int e = i2 / nrw, rl = i2 - e * nrw, R = rbeg + rl;
            const size_t ai = R < NLAT ? ((size_t)((R >> 12) * 16 + e) * SEQ + (R & (SEQ - 1))) : ((size_t)NLAT * 16 + (size_t)(((R - NLAT) >> 8) * 16 + e) * CTXL + ((R - NLAT) & (CTXL - 1)));
            aff[ai] = affb[e * 64 + rl]; } }
}

template <int NPL> __device__ __forceinline__ void topk_wave(const float* affset, int rowbase, int k, int outbase, int* selt, float* selg, int* slotT, unsigned* kl, int* sout, int lane) {
    unsigned prefix = 0u;
    {   unsigned key[NPL];
#pragma unroll
        for (int i = 0; i < NPL; ++i) { key[i] = __float_as_uint(affset[lane * NPL + i]); kl[i * 64 + lane] = key[i]; }
        for (int bit = 30; bit >= 0; --bit) {
            const unsigned cand = prefix | (1u << bit); int c = 0;
#pragma unroll
            for (int i = 0; i < NPL; ++i) c += (key[i] >= cand) ? 1 : 0;
            if (wave_sum_i(c, lane) >= k) prefix = cand;
        }
    }
    int cgt = 0, ceq = 0;
#pragma unroll 4
    for (int i = 0; i < NPL; ++i) { const unsigned ky = kl[i * 64 + lane]; cgt += (ky > prefix) ? 1 : 0; ceq += (ky == prefix) ? 1 : 0; }
    const int need_eq = k - wave_sum_i(cgt, lane);
    const int eq0 = wave_incl_scan_i(ceq, lane) - ceq;
    int eq_rank = eq0, csel = 0;
#pragma unroll 4
    for (int i = 0; i < NPL; ++i) { const unsigned ky = kl[i * 64 + lane]; const bool iseq = ky == prefix; const bool sl = (ky > prefix) || (iseq && eq_rank < need_eq); if (iseq) ++eq_rank; csel += sl ? 1 : 0; }
    int pos = wave_incl_scan_i(csel, lane) - csel;
    eq_rank = eq0;
#pragma unroll 4
    for (int i = 0; i < NPL; ++i) { const unsigned ky = kl[i * 64 + lane]; const int R = rowbase + lane * NPL + i; const bool iseq = ky == prefix; const bool sl = (ky > prefix) || (iseq && eq_rank < need_eq); if (iseq) ++eq_rank;
        int v = -1;
        if (sl) { const int row = outbase + pos; ++pos; selt[row] = R; selg[row] = __uint_as_float(ky); v = row; }
        if (sout) sout[lane * (NPL + 1) + i] = v; else slotT[lane * NPL + i] = v; }
    if (sout) { asm volatile("" ::: "memory");
#pragma unroll 4
        for (int j = 0; j < NPL; ++j) { const int t = j * 64 + lane; slotT[t] = sout[(t / NPL) * (NPL + 1) + (t % NPL)]; } }
}
__device__ __forceinline__ void phase_topk(const Params& p, unsigned char* smem, bool with_ctx, const int tid, const int bid, const int nblk) {
    const int lane = tid & 63, wid = __builtin_amdgcn_readfirstlane(tid >> 6), gw = bid * 8 + wid, NGW = nblk * 8;
    const float* aff = (const float*)(p.ws + WS_AFF); int* selt = (int*)(p.ws + WS_SELT); float* selg = (float*)(p.ws + WS_SELG); int* slot = (int*)(p.ws + WS_SLOT);
    unsigned* kl = (unsigned*)(smem + (size_t)wid * 16384);
    const int nitems = with_ctx ? 512 : 256;
    for (int it = (nblk == 256 ? wid * 256 + bid : gw); it < nitems; it += (nblk == 256 ? 2048 : NGW)) {
        const int b = (it & 255) >> 4, e = it & 15;
        int* sout = (nblk == 256) ? (int*)(smem + 102400 + (size_t)wid * 16640) : (int*)nullptr;
        if (it < 256) topk_wave<64>(aff + (size_t)(b * 16 + e) * SEQ, b * SEQ, 512, (b * 16 + e) * 512, selt, selg, slot + (size_t)(b * 16 + e) * SEQ, kl, sout, lane);
        else topk_wave<4>(aff + (size_t)NLAT * 16 + (size_t)(b * 16 + e) * CTXL, NLAT + b * CTXL, 32, (256 + e) * 512 + b * 32, selt, selg, slot + (size_t)NLAT * 16 + (size_t)(b * 16 + e) * CTXL, kl, sout, lane);
    }
}

__device__ __forceinline__ void phase_resid2(const Params& p, int l, int nrows, unsigned char* smem, const int tid, const int bid, const int nblk) {
    const int lane = tid & 63, wid = __builtin_amdgcn_readfirstlane(tid >> 6), gw = bid * 8 + wid, NGW = nblk * 8;
    const int* slot = (const int*)(p.ws + WS_SLOT); const bf16_t* YE = (const bf16_t*)(p.ws + WS_YE); const float* mod = (const float*)(p.ws + WS_MOD);
    const bf16_t* ZR = (const bf16_t*)(p.ws + WS_ZROW);
    bf16_t* H = (bf16_t*)(p.ws + WS_H); const float* g3 = p.norm_g + (l * 4 + 3) * D;
    const int rpw = (nrows / 2 + NGW - 1) / NGW * 2, rbeg = gw * rpw, rend = (rbeg + rpw < nrows) ? rbeg + rpw : nrows;
    f32x4 cg3[4], cg0[4], cgt[4], csh[4], csc[4]; int cur_r = -1;
#pragma unroll
    for (int j = 0; j < 4; ++j) { cg3[j] = *(const f32x4*)(g3 + 256 * j + 4 * lane); cg0[j] = *(const f32x4*)(p.norm_g + (((l + 1 < DEPTH) ? l + 1 : l) * 4 + 0) * D + 256 * j + 4 * lane); }
    int* sls = (int*)(smem + (size_t)wid * 4096);
    { const int nrw = rend > rbeg ? rend - rbeg : 0, nint = nrw * 16;
        if (nrw > 0 && nrw <= 36) {
            int sv[9], si[9];
#pragma unroll
            for (int q = 0; q < 9; ++q) { const int i = lane + 64 * q, ic = i < nint ? i : 0; const int e = ic / nrw, rl = ic - e * nrw, R = rbeg + rl;
                const size_t a = R < NLAT ? ((size_t)((R >> 12) * 16 + e) * SEQ + (R & (SEQ - 1))) : ((size_t)NLAT * 16 + (size_t)(((R - NLAT) >> 8) * 16 + e) * CTXL + ((R - NLAT) & (CTXL - 1)));
                sv[q] = slot[a]; si[q] = i < nint ? rl * 16 + e : -1; }
#pragma unroll
            for (int q = 0; q < 9; ++q) if (si[q] >= 0) sls[si[q]] = sv[q];
        } else
        for (int i = lane; i < nint; i += 64) { const int e = i / nrw, rl = i - e * nrw, R = rbeg + rl;
            const size_t a = R < NLAT ? ((size_t)((R >> 12) * 16 + e) * SEQ + (R & (SEQ - 1))) : ((size_t)NLAT * 16 + (size_t)(((R - NLAT) >> 8) * 16 + e) * CTXL + ((R - NLAT) & (CTXL - 1)));
            sls[rl * 16 + e] = slot[a]; } }
    asm volatile("s_waitcnt vmcnt(0) lgkmcnt(0)" ::: "memory");
    for (int R0 = rbeg; R0 < rend; R0 += 2) {
        int sl[2][16];
#pragma unroll
        for (int k = 0; k < 2; ++k) { const int4* sp = (const int4*)(sls + (size_t)(R0 + k - rbeg) * 16);
#pragma unroll
            for (int q = 0; q < 4; ++q) { const int4 t = sp[q]; sl[k][4 * q] = __builtin_amdgcn_readfirstlane(t.x); sl[k][4 * q + 1] = __builtin_amdgcn_readfirstlane(t.y); sl[k][4 * q + 2] = __builtin_amdgcn_readfirstlane(t.z); sl[k][4 * q + 3] = __builtin_amdgcn_readfirstlane(t.w); } }
        int cnt[2]; const bf16_t* rp[2][4];
#pragma unroll
        for (int k = 0; k < 2; ++k) { int c = 0, r0 = -1, r1 = -1, r2 = -1, r3 = -1;
#pragma unroll
            for (int e = 0; e < 16; ++e) { const int v = sl[k][e]; const bool ok = v >= 0;
                r0 = (ok && c == 0) ? v : r0; r1 = (ok && c == 1) ? v : r1; r2 = (ok && c == 2) ? v : r2; r3 = (ok && c == 3) ? v : r3; c += ok ? 1 : 0; }
            cnt[k] = c; rp[k][0] = r0 >= 0 ? YE + (size_t)r0 * D : ZR; rp[k][1] = r1 >= 0 ? YE + (size_t)r1 * D : ZR; rp[k][2] = r2 >= 0 ? YE + (size_t)r2 * D : ZR; rp[k][3] = r3 >= 0 ? YE + (size_t)r3 * D : ZR; }
        u32x2 ly[2][4][4]; f32x4 lx[2][4];
#pragma unroll
        for (int k = 0; k < 2; ++k) { const bf16_t* xo = (l == DEPTH - 1) ? xl_ptr(p, R0 + k) : xb_ptr(p, R0 + k);
#pragma unroll
            for (int q = 0; q < 4; ++q) {
                if (q < 2 || cnt[k] > q) {
#pragma unroll
                    for (int j = 0; j < 4; ++j) ly[k][q][j] = *(const u32x2*)(rp[k][q] + 256 * j + 4 * lane); }
                else {
#pragma unroll
                    for (int j = 0; j < 4; ++j) ly[k][q][j] = (u32x2){0u, 0u}; } }
#pragma unroll
            for (int j = 0; j < 4; ++j) lx[k][j] = unpack4(*(const u32x2*)(xo + 256 * j + 4 * lane)); }
#pragma unroll
        for (int k = 0; k < 2; ++k) {
            const int R = R0 + k;
            { const int mr = __builtin_amdgcn_readfirstlane(row_modr(R)); if (mr != cur_r) { cur_r = mr; const float* md = mod + (size_t)(l * 17 + mr) * NMOD; const float* md2 = mod + (size_t)(((l + 1 < DEPTH) ? l + 1 : l) * 17 + mr) * NMOD;
#pragma unroll
                    for (int j = 0; j < 4; ++j) { const int i = 256 * j + 4 * lane; cgt[j] = *(const f32x4*)(md + 5 * D + i); csh[j] = *(const f32x4*)(md2 + i); csc[j] = *(const f32x4*)(md2 + D + i); } } }
            f32x4 yv[4];
#pragma unroll
            for (int j = 0; j < 4; ++j) { yv[j] = (f32x4){0.f, 0.f, 0.f, 0.f};
#pragma unroll
                for (int q = 0; q < 4; ++q) { const u32x2 t = ly[k][q][j]; yv[j] = yv[j] + (f32x4){lo_bf(t.x), hi_bf(t.x), lo_bf(t.y), hi_bf(t.y)}; } }
            if (cnt[k] > 4) { int c = 0;
                for (int e = 0; e < 16; ++e) { const int v = sl[k][e]; if (v >= 0) { if (c >= 4) {
#pragma unroll
                            for (int j = 0; j < 4; ++j) { const u32x2 t = *(const u32x2*)(YE + (size_t)v * D + 256 * j + 4 * lane); yv[j] = yv[j] + (f32x4){lo_bf(t.x), hi_bf(t.x), lo_bf(t.y), hi_bf(t.y)}; } }
                        ++c; } } }
            float ss = 0.f;
#pragma unroll
            for (int j = 0; j < 4; ++j) ss += yv[j].x * yv[j].x + yv[j].y * yv[j].y + yv[j].z * yv[j].z + yv[j].w * yv[j].w;
            const float rstd = rsqrtf(wave_sum(ss, lane) * (1.f / D) + EPS);
            f32x4 xv[4]; float ss2 = 0.f;
#pragma unroll
            for (int j = 0; j < 4; ++j) { const int i = 256 * j + 4 * lane;
                xv[j] = lx[k][j] + cgt[j] * (yv[j] * rstd * cg3[j]);
                if (l == DEPTH - 1) *(f32x4*)(p.out + (size_t)R * D + i) = xv[j];
                else { u32x2 o; o.x = pk2(xv[j].x, xv[j].y); o.y = pk2(xv[j].z, xv[j].w); *(u32x2*)(xb_ptr(p, R) + i) = o; xv[j] = unpack4(o); }
                ss2 += xv[j].x * xv[j].x + xv[j].y * xv[j].y + xv[j].z * xv[j].z + xv[j].w * xv[j].w; }
            if (l + 1 < DEPTH) { const float rstd2 = rsqrtf(wave_sum(ss2, lane) * (1.f / D) + EPS); bf16_t* hrow = H + (size_t)R * D;
#pragma unroll
                for (int j = 0; j < 4; ++j) { const f32x4 hq = xv[j] * rstd2 * cg0[j] * (csc[j] + 1.f) + csh[j]; u32x2 o; o.x = pk2(hq.x, hq.y); o.y = pk2(hq.z, hq.w); *(u32x2*)(hrow + 256 * j + 4 * lane) = o; } }
        }
    }
}

enum { PH_MODS = 0, PH_H0, PH_INPROJ, PH_CONV, PH_PREP, PH_SCAN, PH_MERGE, PH_OUTPROJ, PH_RESID1, PH_TOPK, PH_GATHER, PH_MOE1, PH_MOE2, PH_RESID2, PH_COUNT };

template <int PH> __device__ __forceinline__ void run_phase(const Params& p_in, int l, unsigned char* smem, int wid) {
    Params p = p_in; { __attribute__((address_space(1))) unsigned char* wsg = (__attribute__((address_space(1))) unsigned char*)p_in.ws; asm volatile("" : "+s"(wsg)); p.ws = (unsigned char*)wsg; }
    asm volatile("" : "+s"(wid));
    int tid = (int)__builtin_amdgcn_mbcnt_hi(~0u, __builtin_amdgcn_mbcnt_lo(~0u, 0u)), bid = blockIdx.x, nblk = gridDim.x;
    asm volatile("" : "+v"(tid)); tid += wid * 64; asm volatile("" : "+s"(bid)); asm volatile("" : "+s"(nblk));
    const bool last = (l == DEPTH - 1);
    const int nrows = last ? NLAT : NROW;
    const int nrouted = last ? 256 * 512 : 272 * 512;
    PG8_LAS unsigned char* lds = (PG8_LAS unsigned char*)smem;
    if constexpr (PH == PH_MODS) { if (bid == 0) ((unsigned*)(p.ws + WS_ZROW))[tid] = 0u;
        for (int i = bid * 512 + tid; i < DEPTH * 9 * CONV_CH; i += nblk * 512) { const int ll = i / (9 * CONV_CH), rem = i - ll * 9 * CONV_CH, t = rem / CONV_CH, c = rem - t * CONV_CH;
            ((float*)(p.ws + WS_CWT))[i] = p.conv_w[((size_t)ll * CONV_CH + c) * 9 + t]; }
        phase_mods(p, smem, tid, bid, nblk); __syncthreads(); phase_wconv(p, 0, smem, tid, bid, nblk, 0, 0); }
    if constexpr (PH == PH_H0) { phase_h0(p, tid, bid, nblk); }
    if constexpr (PH == PH_INPROJ) {
        pg8::Gemm g{(const bf16_t*)(p.ws + WS_H), (const bf16_t*)(p.ws + WS_WIN), NROW, NPROJ_PAD, D}; pg8::StaticOrder S; S.init(NROW, NPROJ_PAD, nblk, bid);
        EpiInProj E{(bf16_t*)(p.ws + WS_PC), (bf16_t*)(p.ws + WS_PR), (float*)(p.ws + WS_SM)};
        pg8::gemm_phase<EpiInProj, pg8::StaticOrder>(lds, g, S, E, tid);
    }
    if constexpr (PH == PH_CONV) { phase_conv(p, l, tid, bid, nblk); }
#if SCAN_NAIVE
    if constexpr (PH == PH_SCAN) { phase_scan_naive(p, l, smem, !last, tid, bid); }
#else
    if constexpr (PH == PH_PREP) { phase_prep(p, l, smem, tid, bid, nblk); }
    if constexpr (PH == PH_SCAN) { phase_scan_mfma(p, l, smem, !last, tid, bid, nblk); }
#endif
    if constexpr (PH == PH_MERGE) { phase_merge(p, l, nrows, tid, bid, nblk); }
    if constexpr (PH == PH_OUTPROJ) {
        pg8::Gemm g{(const bf16_t*)(p.ws + WS_MIX), (const bf16_t*)(p.ws + WS_WOUT), nrows, D, D}; pg8::StaticOrder S; S.init(nrows, D, nblk, bid);
        EpiPlain E{(bf16_t*)(p.ws + WS_M)};
        pg8::gemm_phase<EpiPlain, pg8::StaticOrder>(lds, g, S, E, tid);
        if (nblk == 256) phase_wconv(p, l, smem, tid, bid, nblk, 2, 512);
    }
    if constexpr (PH == PH_RESID1) { phase_resid1(p, l, smem, nrows, tid, bid, nblk); }
    if constexpr (PH == PH_TOPK) { phase_topk(p, smem, !last, tid, bid, nblk);
        if (nblk == 256) phase_wconv(p, l, smem, tid, bid, nblk, 3, -2); else { __syncthreads(); phase_wconv(p, l, smem, tid, bid, nblk, 1, 0); } }
    if constexpr (PH == PH_MOE1) {
        pg8::Gemm g{(const bf16_t*)(p.ws + WS_H2), (const bf16_t*)(p.ws + WS_WGU), nrouted, 1024, D}; pg8::MoeOrder S{nrouted / 256, nblk, bid};
        EpiSwiGLU E{(bf16_t*)(p.ws + WS_HID)};
        pg8::gemm_phase_gather<EpiSwiGLU, pg8::MoeOrder>(lds, g, S, E, tid, (const int*)(p.ws + WS_SELT));
    }
    if constexpr (PH == PH_MOE2) {
        pg8::Gemm g{(const bf16_t*)(p.ws + WS_HID), (const bf16_t*)(p.ws + WS_WD), nrouted, 1024, 512}; pg8::MoeOrder S{nrouted / 256, nblk, bid};
        EpiDown E{(bf16_t*)(p.ws + WS_YE), (const float*)(p.ws + WS_SELG)};
        pg8::gemm_phase<EpiDown, pg8::MoeOrder>(lds, g, S, E, tid);
    }
    if constexpr (PH == PH_RESID2) { phase_resid2(p, l, nrows, smem, tid, bid, nblk); if (!last) { __syncthreads(); phase_wconv(p, l + 1, smem, tid, bid, nblk, 0, 0); } }
}

#if MK_MULTI
template <int PH> __global__ void __launch_bounds__(512, 2) k_phase(Params p, int l) {
    extern __shared__ __attribute__((aligned(16))) unsigned char smem[];
    run_phase<PH>(p, l, smem, __builtin_amdgcn_readfirstlane((int)threadIdx.x >> 6));
}
#else
__global__ void __launch_bounds__(512, 2) mega(Params p) {
    extern __shared__ __attribute__((aligned(16))) unsigned char smem[];
    const int wid = __builtin_amdgcn_readfirstlane((int)threadIdx.x >> 6);
    uint4* xbw = (uint4*)(smem + LDS_XB_OFF);
    if (threadIdx.x == 0) *xbw = make_uint4(0u, 0u, 0u, 0u);
    __syncthreads();
    const unsigned xcc = xcd_barrier_post((unsigned*)(p.ws + WS_CTL), (volatile LAS unsigned*)xbw, threadIdx.x == 0).x;
#define GRID_BAR() do { unsigned x_ = xcc; int ln_ = (int)__builtin_amdgcn_mbcnt_hi(~0u, __builtin_amdgcn_mbcnt_lo(~0u, 0u)); unsigned char* w_ = p.ws; asm volatile("" : "+s"(x_)); asm volatile("" : "+v"(ln_)); asm volatile("" : "+s"(w_)); \
        XcdBarrier b_; b_.bar = (unsigned*)(w_ + WS_CTL); b_.x = x_; b_.st = (volatile LAS unsigned*)(smem + LDS_XB_OFF); \
        xcd_barrier(b_, wid == 0 && ln_ == 0); } while (0)
    run_phase<PH_MODS>(p, 0, smem, wid); GRID_BAR();
    run_phase<PH_H0>(p, 0, smem, wid); GRID_BAR();
    for (int l = 0; l < DEPTH; ++l) {
        run_phase<PH_INPROJ>(p, l, smem, wid); GRID_BAR();
        if (PROBE_DUP_MASK & (1 << PH_INPROJ)) { run_phase<PH_INPROJ>(p, l, smem, wid); GRID_BAR(); }
        run_phase<PH_CONV>(p, l, smem, wid); GRID_BAR();
        if (PROBE_DUP_MASK & (1 << PH_CONV)) { run_phase<PH_CONV>(p, l, smem, wid); GRID_BAR(); }
#if !SCAN_NAIVE
        run_phase<PH_PREP>(p, l, smem, wid); GRID_BAR();
        if (PROBE_DUP_MASK & (1 << PH_PREP)) { run_phase<PH_PREP>(p, l, smem, wid); GRID_BAR(); }
#endif
        run_phase<PH_SCAN>(p, l, smem, wid); GRID_BAR();
        if (PROBE_DUP_MASK & (1 << PH_SCAN)) { run_phase<PH_SCAN>(p, l, smem, wid); GRID_BAR(); }
        run_phase<PH_MERGE>(p, l, smem, wid); GRID_BAR();
        if (PROBE_DUP_MASK & (1 << PH_MERGE)) { run_phase<PH_MERGE>(p, l, smem, wid); GRID_BAR(); }
        run_phase<PH_OUTPROJ>(p, l, smem, wid); GRID_BAR();
        if (PROBE_DUP_MASK & (1 << PH_OUTPROJ)) { run_phase<PH_OUTPROJ>(p, l, smem, wid); GRID_BAR(); }
        run_phase<PH_RESID1>(p, l, smem, wid); GRID_BAR();
        run_phase<PH_TOPK>(p, l, smem, wid); GRID_BAR();
        if (PROBE_DUP_MASK & (1 << PH_TOPK)) { run_phase<PH_TOPK>(p, l, smem, wid); GRID_BAR(); }
        run_phase<PH_MOE1>(p, l, smem, wid); GRID_BAR();
        if (PROBE_DUP_MASK & (1 << PH_MOE1)) { run_phase<PH_MOE1>(p, l, smem, wid); GRID_BAR(); }
        run_phase<PH_MOE2>(p, l, smem, wid); GRID_BAR();
        if (PROBE_DUP_MASK & (1 << PH_MOE2)) { run_phase<PH_MOE2>(p, l, smem, wid); GRID_BAR(); }
        run_phase<PH_RESID2>(p, l, smem, wid); if (l + 1 < DEPTH) GRID_BAR();
    }
}
#endif

extern "C" void kernel_launch(void* const* d_in, const int* in_sizes, int n_in, void* d_out, int out_size, void* d_ws, size_t ws_size, hipStream_t stream) {
    static int grid = 0;
    if (grid == 0) {
        if (n_in != 22 || out_size != NLAT * D || ws_size < WS_END) { fprintf(stderr, "kernel_launch: unexpected shapes (n_in %d out %d ws %zu)\n", n_in, out_size, ws_size); grid = -1; return; }
        int dev = 0, cus = 0;
        if (hipGetDevice(&dev) != hipSuccess || hipDeviceGetAttribute(&cus, hipDeviceAttributeMultiprocessorCount, dev) != hipSuccess) { grid = -1; return; }
#if MK_MULTI
#define SETATTR(PH) (void)hipFuncSetAttribute((const void*)k_phase<PH>, hipFuncAttributeMaxDynamicSharedMemorySize, LDS_BYTES)
        SETATTR(0); SETATTR(1); SETATTR(2); SETATTR(3); SETATTR(4); SETATTR(5); SETATTR(6); SETATTR(7); SETATTR(8); SETATTR(9); SETATTR(10); SETATTR(11); SETATTR(12); SETATTR(13);
#else
        if (hipFuncSetAttribute((const void*)mega, hipFuncAttributeMaxDynamicSharedMemorySize, LDS_BYTES) != hipSuccess) { fprintf(stderr, "kernel_launch: hipFuncSetAttribute failed\n"); grid = -1; return; }
#endif
        (void)hipGetLastError();
        grid = cus;
    }
    if (grid < 0) return;
    Params p{};
    const float** pin = (const float**)&p;
    for (int i = 0; i < 22; ++i) pin[i] = (const float*)d_in[i];
    p.out = (float*)d_out; p.ws = (unsigned char*)d_ws;
#if MK_MULTI
#define LAUNCH(PH, l) hipLaunchKernelGGL(k_phase<PH>, dim3(grid), dim3(512), LDS_BYTES, stream, p, l)
    LAUNCH(PH_MODS, 0); LAUNCH(PH_H0, 0);
    for (int l = 0; l < DEPTH; ++l) { LAUNCH(PH_INPROJ, l); LAUNCH(PH_CONV, l); LAUNCH(PH_PREP, l); LAUNCH(PH_SCAN, l); LAUNCH(PH_MERGE, l); LAUNCH(PH_OUTPROJ, l); LAUNCH(PH_RESID1, l);
        LAUNCH(PH_TOPK, l); LAUNCH(PH_GATHER, l); LAUNCH(PH_MOE1, l); LAUNCH(PH_MOE2, l); LAUNCH(PH_RESID2, l); }
#else
    (void)hipMemsetAsync((char*)d_ws + WS_CTL, 0, XCD_BAR_WORDS * sizeof(unsigned), stream);
    hipLaunchKernelGGL(mega, dim3(grid), dim3(512), LDS_BYTES, stream, p);
#endif
}
```
